# Optimizing an MI355X kernel written in HIP

```python
import math
import jax, jax.numpy as jnp
from jax import lax
import numpy as np

D_MODEL = 1024
BATCH = 4
SEQ = 4096
DEPTH = 1
DEC_BATCH = 32
DEC_SEQ = 32
PAST_LEN = 2048

CHUNK = 64
D_CONV = 1024
CONV_WIDTH = 3
D_SSM = 1024
GROUP_SIZE = 16
N_GROUPS = D_SSM // GROUP_SIZE
STATE_DIM = 64
D_FF = 2816
N_IN = 3 * D_CONV + D_SSM + 2 * D_MODEL
RMS_EPS = 1e-6
DT_MIN = 1e-3
DT_MAX = 1e-1

kernel_name = "hybrid_shortconv_s5_macaron_step"


def rms_norm(x, g):
    xf = x.astype(jnp.float32)
    y = xf * lax.rsqrt(jnp.mean(xf * xf, axis=-1, keepdims=True) + RMS_EPS)
    return (y * g.astype(jnp.float32)).astype(x.dtype)


def swiglu(h, wg, wu, wd):
    return (jax.nn.silu(h @ wg) * (h @ wu)) @ wd


def short_conv(z, prev, w):
    L = z.shape[1]
    zp = jnp.concatenate([prev.astype(z.dtype), z], axis=1)
    out = w[0] * zp[:, 0:L]
    for k in range(1, CONV_WIDTH):
        out = out + w[k] * zp[:, k:k + L]
    return out, zp[:, L:]


def s5_scan(u, h0, lam_re, lam_im, log_step, b_re, b_im, c_re, c_im, d_skip):
    f32 = jnp.float32
    bsz, L, _ = u.shape
    uf = u.astype(f32)
    ug = uf.reshape(bsz, L, N_GROUPS, GROUP_SIZE)
    lam = lax.complex(lam_re.astype(f32), lam_im.astype(f32))
    step = jnp.exp(log_step.astype(f32))[:, None]
    lam_bar = jnp.exp(lam * step)
    b_bar = ((lam_bar - 1.0) / lam)[..., None] * lax.complex(b_re.astype(f32), b_im.astype(f32))
    bu = lax.complex(jnp.einsum('gpc,blgc->blgp', jnp.real(b_bar), ug),
                     jnp.einsum('gpc,blgc->blgp', jnp.imag(b_bar), ug))
    a = jnp.broadcast_to(lam_bar, bu.shape)

    def combine(left, right):
        a1, b1 = left
        a2, b2 = right
        return a2 * a1, a2 * b1 + b2

    a_cum, h = lax.associative_scan(combine, (a, bu), axis=1)
    if h0 is not None:
        h = h + a_cum * lax.complex(h0[0].astype(f32), h0[1].astype(f32))[:, None]
    c = lax.complex(c_re.astype(f32), c_im.astype(f32))
    y = jnp.real(jnp.einsum('gcp,blgp->blgc', c, h)).reshape(bsz, L, D_SSM)
    y = y + d_skip.astype(f32) * uf
    h_last = h[:, -1]
    return y.astype(u.dtype), jnp.real(h_last).astype(u.dtype), jnp.imag(h_last).astype(u.dtype)


def mixer(h, conv_prev, h0, w_in, w_conv, w_conv_out, lam_re, lam_im, log_step,
          b_re, b_im, c_re, c_im, d_skip, w_glu, w_o):
    proj = h @ w_in
    v, c_gate, b_gate, u, g_conv, g_ssm = jnp.split(
        proj, [D_CONV, 2 * D_CONV, 3 * D_CONV, 3 * D_CONV + D_SSM, 3 * D_CONV + D_SSM + D_MODEL], axis=-1)
    conv_out, conv_state = short_conv(c_gate * v, conv_prev, w_conv)
    y_conv = (b_gate * conv_out) @ w_conv_out
    y_s, s_re, s_im = s5_scan(u, h0, lam_re, lam_im, log_step, b_re, b_im, c_re, c_im, d_skip)
    glu = jax.nn.gelu(y_s) @ w_glu
    y_ssm = glu[..., :D_MODEL] * jax.nn.sigmoid(glu[..., D_MODEL:])
    merged = jax.nn.sigmoid(g_conv) * y_conv + jax.nn.sigmoid(g_ssm) * y_ssm
    return merged @ w_o, conv_state, s_re, s_im


def trunk(x, conv_prev, ssm_re0, ssm_im0, params):
    (norm_ffn1, w_ffn1_gate, w_ffn1_up, w_ffn1_down, norm_mix, w_in, w_conv, w_conv_out,
     ssm_lambda_re, ssm_lambda_im, ssm_log_step, ssm_b_re, ssm_b_im, ssm_c_re, ssm_c_im, ssm_d,
     w_glu, w_o, norm_ffn2, w_ffn2_gate, w_ffn2_up, w_ffn2_down, norm_final) = params
    convs, res, ims = [], [], []
    for l in range(DEPTH):
        x = x + 0.5 * swiglu(rms_norm(x, norm_ffn1[l]), w_ffn1_gate[l], w_ffn1_up[l], w_ffn1_down[l])
        if conv_prev is None:
            prev = jnp.zeros((x.shape[0], CONV_WIDTH - 1, D_CONV), x.dtype)
            h0 = None
        else:
            prev = conv_prev[l]
            h0 = (ssm_re0[l], ssm_im0[l])
        mix, cs, sre, sim = mixer(rms_norm(x, norm_mix[l]), prev, h0, w_in[l], w_conv[l], w_conv_out[l],
                                  ssm_lambda_re[l], ssm_lambda_im[l], ssm_log_step[l], ssm_b_re[l], ssm_b_im[l],
                                  ssm_c_re[l], ssm_c_im[l], ssm_d[l], w_glu[l], w_o[l])
        x = x + mix
        x = x + 0.5 * swiglu(rms_norm(x, norm_ffn2[l]), w_ffn2_gate[l], w_ffn2_up[l], w_ffn2_down[l])
        convs.append(cs)
        res.append(sre)
        ims.append(sim)
    return rms_norm(x, norm_final), jnp.stack(convs), jnp.stack(res), jnp.stack(ims)


def setup_inputs(seed: int = 0) -> dict:
    key = jax.random.key(seed)
    k = jax.random.split(key, 32)
    f32 = jnp.float32

    def nrm(i, shape, scale):
        return jax.random.normal(k[i], shape, f32) * scale

    def gain(i, shape):
        return 1.0 + 0.01 * jax.random.normal(k[i], shape, f32)

    lam_im = jnp.broadcast_to(math.pi * jnp.arange(STATE_DIM, dtype=f32), (DEPTH, N_GROUPS, STATE_DIM))
    return {
        "x_prompt": nrm(0, (BATCH, SEQ, D_MODEL), 1.0),
        "x_sample": nrm(1, (DEC_BATCH, DEC_SEQ, D_MODEL), 1.0),
        "state_conv": nrm(2, (DEPTH, DEC_BATCH, CONV_WIDTH - 1, D_CONV), 1.0),
        "state_ssm_re": nrm(3, (DEPTH, DEC_BATCH, N_GROUPS, STATE_DIM), 0.1),
        "state_ssm_im": nrm(4, (DEPTH, DEC_BATCH, N_GROUPS, STATE_DIM), 0.1),
        "norm_ffn1": gain(5, (DEPTH, D_MODEL)),
        "w_ffn1_gate": nrm(6, (DEPTH, D_MODEL, D_FF), D_MODEL ** -0.5),
        "w_ffn1_up": nrm(7, (DEPTH, D_MODEL, D_FF), D_MODEL ** -0.5),
        "w_ffn1_down": nrm(8, (DEPTH, D_FF, D_MODEL), D_FF ** -0.5),
        "norm_mix": gain(9, (DEPTH, D_MODEL)),
        "w_in": nrm(10, (DEPTH, D_MODEL, N_IN), D_MODEL ** -0.5),
        "w_conv": nrm(11, (DEPTH, CONV_WIDTH, D_CONV), CONV_WIDTH ** -0.5),
        "w_conv_out": nrm(12, (DEPTH, D_CONV, D_MODEL), D_CONV ** -0.5),
        "ssm_lambda_re": -0.5 + nrm(13, (DEPTH, N_GROUPS, STATE_DIM), 0.01),
        "ssm_lambda_im": lam_im + nrm(14, (DEPTH, N_GROUPS, STATE_DIM), 0.01),
        "ssm_log_step": jax.random.uniform(k[15], (DEPTH, N_GROUPS), f32,
                                           minval=math.log(DT_MIN), maxval=math.log(DT_MAX)),
        "ssm_b_re": nrm(16, (DEPTH, N_GROUPS, STATE_DIM, GROUP_SIZE), (2 * GROUP_SIZE) ** -0.5),
        "ssm_b_im": nrm(17, (DEPTH, N_GROUPS, STATE_DIM, GROUP_SIZE), (2 * GROUP_SIZE) ** -0.5),
        "ssm_c_re": nrm(18, (DEPTH, N_GROUPS, GROUP_SIZE, STATE_DIM), STATE_DIM ** -0.5),
        "ssm_c_im": nrm(19, (DEPTH, N_GROUPS, GROUP_SIZE, STATE_DIM), STATE_DIM ** -0.5),
        "ssm_d": nrm(20, (DEPTH, D_SSM), 1.0),
        "w_glu": nrm(21, (DEPTH, D_SSM, 2 * D_MODEL), D_SSM ** -0.5),
        "w_o": nrm(22, (DEPTH, D_MODEL, D_MODEL), D_MODEL ** -0.5),
        "norm_ffn2": gain(23, (DEPTH, D_MODEL)),
        "w_ffn2_gate": nrm(24, (DEPTH, D_MODEL, D_FF), D_MODEL ** -0.5),
        "w_ffn2_up": nrm(25, (DEPTH, D_MODEL, D_FF), D_MODEL ** -0.5),
        "w_ffn2_down": nrm(26, (DEPTH, D_FF, D_MODEL), D_FF ** -0.5),
        "norm_final": gain(27, (D_MODEL,)),
    }


def reference(x_prompt, x_sample, state_conv, state_ssm_re, state_ssm_im,
              norm_ffn1, w_ffn1_gate, w_ffn1_up, w_ffn1_down, norm_mix, w_in, w_conv, w_conv_out,
              ssm_lambda_re, ssm_lambda_im, ssm_log_step, ssm_b_re, ssm_b_im, ssm_c_re, ssm_c_im, ssm_d,
              w_glu, w_o, norm_ffn2, w_ffn2_gate, w_ffn2_up, w_ffn2_down, norm_final):
    params = (norm_ffn1, w_ffn1_gate, w_ffn1_up, w_ffn1_down, norm_mix, w_in, w_conv, w_conv_out,
              ssm_lambda_re, ssm_lambda_im, ssm_log_step, ssm_b_re, ssm_b_im, ssm_c_re, ssm_c_im, ssm_d,
              w_glu, w_o, norm_ffn2, w_ffn2_gate, w_ffn2_up, w_ffn2_down, norm_final)
    y_prompt, conv_p, ssm_re_p, ssm_im_p = trunk(x_prompt, None, None, None, params)
    y_sample, conv_s, ssm_re_s, ssm_im_s = trunk(x_sample, state_conv, state_ssm_re, state_ssm_im, params)
    return (y_prompt, y_sample, conv_p, ssm_re_p, ssm_im_p, conv_s, ssm_re_s, ssm_im_s)
```

```cpp
#include <hip/hip_runtime.h>
#include <cstdio>
#include <cstdint>

#ifndef NSPLIT
#define NSPLIT 8
#endif
#ifndef PG8_SP2
#define PG8_SP2 1
#endif
#ifndef DUP_CONV
#define DUP_CONV 0
#endif
#ifndef MK_N_LAUNCHES
#define MK_N_LAUNCHES 1
#endif

constexpr int MP = 16384, MS = 1024, M = MP + MS;
constexpr int D = 1024, FF = 2816, NIN = 6144, NG = 64, NP = 64;
constexpr int SEQ = 4096, DSEQ = 32, NB = 4, NDB = 32;
constexpr float RMS_EPS = 1e-6f;
constexpr size_t O_Y = 0, O_CONVP = (size_t)M * D, O_SREP = O_CONVP + 8192, O_SIMP = O_SREP + 16384, O_CONVS = O_SIMP + 16384, O_SRES = O_CONVS + 65536, O_SIMS = O_SRES + 131072;

#define GAS __attribute__((address_space(1)))
#define LAS __attribute__((address_space(3)))
typedef unsigned short bf16_t;
typedef short bf16x8 __attribute__((ext_vector_type(8)));
typedef float f32x4 __attribute__((ext_vector_type(4)));
typedef float f32x2 __attribute__((ext_vector_type(2)));
typedef unsigned u32x4 __attribute__((ext_vector_type(4)));
typedef unsigned u32x2 __attribute__((ext_vector_type(2)));

__device__ __forceinline__ unsigned cvt_pk_bf16(float lo, float hi) { unsigned r; asm volatile("v_cvt_pk_bf16_f32 %0, %1, %2" : "=v"(r) : "v"(lo), "v"(hi)); return r; }
__device__ __forceinline__ float bf_lo(unsigned w) { return __uint_as_float(w << 16); }
__device__ __forceinline__ float bf_hi(unsigned w) { return __uint_as_float(w & 0xffff0000u); }
__device__ __forceinline__ float sigmoid_f(float v) { return __builtin_amdgcn_rcpf(1.0f + __builtin_amdgcn_exp2f(-1.4426950409f * v)); }
__device__ __forceinline__ float silu_f(float v) { return v * sigmoid_f(v); }
__device__ __forceinline__ float gelu_tanh_f(float v) { return v * sigmoid_f(1.5957691216f * (v + 0.044715f * v * v * v)); }

__device__ __forceinline__ void st16_wt(void* p, u32x4 v) { asm volatile("global_store_dwordx4 %0, %1, off sc1\n\ts_nop 1" :: "v"(p), "v"(v) : "memory"); }
#ifdef WT_STORES
__device__ __forceinline__ void st16(void* p, u32x4 v) { asm volatile("global_store_dwordx4 %0, %1, off sc1\n\ts_nop 1" :: "v"(p), "v"(v) : "memory"); }
__device__ __forceinline__ void st8(void* p, u32x2 v) { asm volatile("global_store_dwordx2 %0, %1, off sc1\n\ts_nop 1" :: "v"(p), "v"(v) : "memory"); }
#else
__device__ __forceinline__ void st16(void* p, u32x4 v) { *(u32x4*)p = v; }
__device__ __forceinline__ void st8(void* p, u32x2 v) { *(u32x2*)p = v; }
#endif

__device__ __forceinline__ u32x2 pack_unorm8(const float (&o)[8]) {
    u32x2 w = {0u, 0u};
#pragma unroll
    for (int j = 0; j < 4; ++j) { w.x = __builtin_amdgcn_cvt_pk_u8_f32(fmaf(o[j], 255.0f, 0.5f), j, w.x); w.y = __builtin_amdgcn_cvt_pk_u8_f32(fmaf(o[4 + j], 255.0f, 0.5f), j, w.y); }
    return w;
}
__device__ __forceinline__ float unorm8(unsigned w, int j) { return (float)((w >> (8 * j)) & 0xffu) * (1.0f / 255.0f); }

constexpr int RING_BYTES = 131072;
constexpr int SCR_OFF = RING_BYTES;
constexpr int LDS_BYTES = 163840;
constexpr int LDSCTL_OFF = LDS_BYTES - 512;

namespace pg8 {
constexpr int BM = 256, BK = 64, HALF = 128, HTB = HALF * BK * 2, NXCD = 8, WGM = 8;
__host__ __device__ __forceinline__ int lds_byte(int r, int c) { const int st = (r >> 4) * 2 + (c >> 5), rr = r & 15, cc = c & 31, ob = rr * 64 + cc * 2; return st * 1024 + (ob ^ (((ob >> 9) & 1) << 5)); }
__host__ __device__ __forceinline__ void stage_rc(int b, int& R, int& C) { const int st = b / 1024, sb = b % 1024, swz = sb ^ (((sb >> 9) & 1) << 5); R = (st >> 1) * 16 + swz / 64; C = (st & 1) * 32 + (swz % 64) / 2; }
__host__ __device__ __forceinline__ int perm32(int rho) { const int n = rho >> 4, i = rho & 15; return 8 * (i >> 2) + 4 * n + (i & 3); }

struct Unit { int pm, pn, kt0, nkt, part, tidx; };
struct Gemm { const bf16_t* A; const bf16_t* Bt; int M, N, K; unsigned a_rs, a_gs; };

struct StaticOrder {
    int nM, nN, nwg, G, c, nkt, ns, q, r, mp;
    __host__ __device__ __forceinline__ void init(int M_, int N_, int K_, int G_, int c_, int ns_) { nM = M_ / BM; nN = N_ / BM; nwg = nM * nN; G = G_; c = c_; nkt = K_ / BK; ns = ns_; q = nwg / G; r = nwg - q * G; mp = nM; if (ns != 8 || r == 0 || r * ns > G || nkt < 16) ns = 1; }
    __host__ __device__ __forceinline__ bool init_tailpanels(int M_, int N_, int K_, int G_, int c_, int tp) { nM = M_ / BM; nN = N_ / BM; nwg = nM * nN; G = G_; c = c_; nkt = K_ / BK; ns = 8; mp = nM - tp;
        q = (mp * nN) / G; r = tp * nN; return (mp * nN == q * G) && (r * ns <= G) && nkt >= 16; }
    __host__ __device__ __forceinline__ void tile(int L, Unit& u) const {
        const int nm = mp, nw = mp * nN;
        if (L >= nw) { const int j = L - nw; u.pm = mp + j / nN; u.pn = j % nN; return; }
        int wgid = L; { const int qq = nw / NXCD, rr = nw % NXCD, xcd = wgid % NXCD, off = wgid / NXCD; wgid = (xcd < rr ? xcd * (qq + 1) : rr * (qq + 1) + (xcd - rr) * qq) + off; }
        const int nig = WGM * nN, gid = wgid / nig, fm = gid * WGM, gsz = (nm - fm) < WGM ? (nm - fm) : WGM;
        u.pm = fm + ((wgid % nig) % gsz); u.pn = (wgid % nig) / gsz;
    }
    __device__ __forceinline__ void after_unit(int, int) const {}
    __host__ __device__ __forceinline__ bool next(int i, Unit& u) const {
        u.kt0 = 0; u.nkt = nkt; u.part = -1; u.tidx = 0;
        if (ns > 1) {
            const bool has_tail = c < r * ns;
            if (has_tail && i == 0) { u.tidx = c / ns; u.part = c % ns; tile(q * G + u.tidx, u);
                const int pairs = nkt / 2, p0 = u.part * pairs / ns, p1 = (u.part + 1) * pairs / ns; u.kt0 = 2 * p0; u.nkt = 2 * (p1 - p0); return true; }
            const int j = has_tail ? i - 1 : i; if (j >= q) return false;
            tile(j * G + c, u); return true; }
        const long L = (long)i * G + c; if (L >= nwg) return false;
        tile((int)L, u); return true;
    }
};

constexpr int ZF_N1 = 12;
struct ZFirstOrder {
    StaticOrder A, B; int nA, nB, G, c, nkt, last_a; unsigned* done;
    __device__ __forceinline__ void init(int G_, int c_, unsigned* done_) { G = G_; c = c_; done = done_; A.init(M, ZF_N1 * BM, D, G_, c_, 1); B.init(M, (NIN / BM - ZF_N1) * BM, D, G_, c_, 1); nA = A.nwg; nB = B.nwg; nkt = D / BK;
        last_a = (c < nA) ? (nA - 1 - c) / G : -1; }
    __device__ __forceinline__ bool next(int i, Unit& u) const {
        u.kt0 = 0; u.nkt = nkt; u.part = -1; u.tidx = 0; const int L = i * G + c;
        if (L < nA) { A.tile(L, u); return true; }
        if (L < nA + nB) { B.tile(L - nA, u); u.pn += ZF_N1; return true; }
        return false;
    }
    __device__ __forceinline__ void after_unit(int ui, int tid) const {
        if (ui != last_a) return;
        asm volatile("s_waitcnt vmcnt(0)" ::: "memory"); __syncthreads();
        if (tid == 0) { __builtin_amdgcn_fence(__ATOMIC_RELEASE, "agent"); asm volatile("s_waitcnt vmcnt(0)" ::: "memory"); __hip_atomic_fetch_add(done, 1u, __ATOMIC_RELAXED, __HIP_MEMORY_SCOPE_AGENT); }
    }
    __device__ __forceinline__ int publishers() const { return nA < G ? nA : G; }
    __device__ __forceinline__ bool has_last_round_unit() const { return ((nA + nB - 1) / G) * G + c < nA + nB; }
};

typedef f32x4 Acc[2][2][4][2];

__device__ __forceinline__ float rrms_of(const float* ss, int row) { const f32x4 p = *(const f32x4*)(ss + (size_t)row * 4); return rsqrtf(((p[0] + p[1]) + (p[2] + p[3])) * (1.0f / D) + RMS_EPS); }

typedef f32x4 Slice[2][2];
struct EpiSwiGLU {
    static constexpr bool PERM = true, IDEM = true, RSCALE = true, FINAL = false; static constexpr int BATCH = 1;
    bf16_t* H; const float* ss;
    struct In {};
    __device__ __forceinline__ In load(const Unit&, int, int, int, int, int, int) const { return In{}; }
    __device__ __forceinline__ void rows(const Slice& v, const In&, const Unit& u, int ai, int m, int wr, int wc, int fr, int fq, LAS float* scr) const {
        const int rt = ai * HALF + wr * 64 + m * 16 + fr, row = u.pm * BM + rt, col0 = u.pn * HALF + wc * 32 + 8 * fq; const float s = scr[rt], s2 = s * s, sl = -1.4426950409f * s;
        float o[8];
#pragma unroll
        for (int n = 0; n < 2; ++n)
#pragma unroll
            for (int j = 0; j < 4; ++j) { const float gg = v[0][n][j]; o[n * 4 + j] = (gg * v[1][n][j]) * (s2 * __builtin_amdgcn_rcpf(1.0f + __builtin_amdgcn_exp2f(gg * sl))); }
        u32x4 w; w.x = cvt_pk_bf16(o[0], o[1]); w.y = cvt_pk_bf16(o[2], o[3]); w.z = cvt_pk_bf16(o[4], o[5]); w.w = cvt_pk_bf16(o[6], o[7]);
        st16(H + (size_t)row * FF + col0, w);
    }
    __device__ __forceinline__ void finish(const Unit&, LAS unsigned char*, int, int) const {}
};

template <bool BASE_BF16, bool OUT_F32, bool OUT_BF16>
struct EpiResid {
    static constexpr bool PERM = false, IDEM = true, RSCALE = false, FINAL = false; static constexpr int BATCH = BASE_BF16 ? 8 : 4;
    const float* base_p; const float* base_s; const bf16_t* base_b; float* out; bf16_t* xb; float* ss; float alpha;
    struct In { f32x4 b[2][2]; u32x2 w[2][2]; };
    __device__ __forceinline__ In load(const Unit& u, int ai, int m, int wr, int wc, int fr, int fq) const {
        const int row = u.pm * BM + ai * HALF + wr * 64 + m * 16 + fr, col0 = u.pn * BM + wc * 32 + 4 * fq; const size_t off = (size_t)row * D + col0;
        const float* base = (u.pm < MP / BM) ? base_p : (base_s - (size_t)MP * D); In in;
#pragma unroll
        for (int bj = 0; bj < 2; ++bj)
#pragma unroll
            for (int n = 0; n < 2; ++n) {
                if (BASE_BF16) in.w[bj][n] = *(const u32x2*)(base_b + off + bj * HALF + n * 16);
                else in.b[bj][n] = *(const f32x4*)(base + off + bj * HALF + n * 16); }
        return in;
    }
    __device__ __forceinline__ void rows(const Slice& v, const In& in, const Unit& u, int ai, int m, int wr, int wc, int fr, int fq, LAS float* scr) const {
        const int rt = ai * HALF + wr * 64 + m * 16 + fr, row = u.pm * BM + rt, col0 = u.pn * BM + wc * 32 + 4 * fq;
        const size_t off = (size_t)row * D + col0; float sq = 0.f;
#pragma unroll
        for (int bj = 0; bj < 2; ++bj)
#pragma unroll
            for (int n = 0; n < 2; ++n) { f32x4 b; if (BASE_BF16) { const u32x2 w = in.w[bj][n]; b = (f32x4){bf_lo(w.x), bf_hi(w.x), bf_lo(w.y), bf_hi(w.y)}; } else b = in.b[bj][n];
                const f32x4 x = b + alpha * v[bj][n];
                if (OUT_F32) *(f32x4*)(out + off + bj * HALF + n * 16) = x;
                sq += (x[0] * x[0] + x[1] * x[1]) + (x[2] * x[2] + x[3] * x[3]);
                if (OUT_BF16) { u32x2 w; w.x = cvt_pk_bf16(x[0], x[1]); w.y = cvt_pk_bf16(x[2], x[3]); st8(xb + off + bj * HALF + n * 16, w); } }
        sq += __shfl_xor(sq, 16); sq += __shfl_xor(sq, 32);
        if (fq == 0) scr[rt * 4 + wc] = sq;
    }
    __device__ __forceinline__ void finish(const Unit& u, LAS unsigned char* lds, int tid, int sel) const {
        LAS float* scr = (LAS float*)(lds + SCR_OFF);
        asm volatile("s_waitcnt lgkmcnt(0)" ::: "memory"); __builtin_amdgcn_s_barrier(); asm volatile("" ::: "memory");
        if (tid < 256 && (sel < 0 || (((tid >> 7) * 4 + ((tid >> 4) & 3)) == sel))) { const f32x4 p = *(const LAS f32x4*)(scr + tid * 4); ss[(size_t)(u.pm * BM + tid) * 4 + u.pn] = (p[0] + p[1]) + (p[2] + p[3]); }
    }
};

struct EpiMixIn {
    static constexpr bool PERM = true, IDEM = true, RSCALE = true, FINAL = false; static constexpr int BATCH = 1;
    bf16_t *Z, *BG, *U; unsigned char *SG8C, *SG8S; const float* ss; float* dout;
    struct In {};
    __device__ __forceinline__ In load(const Unit&, int, int, int, int, int, int) const { return In{}; }
    __device__ __forceinline__ void rows(const Slice& v, const In&, const Unit& u, int ai, int m, int wr, int wc, int fr, int fq, LAS float* scr) const {
        const int rt = ai * HALF + wr * 64 + m * 16 + fr, row = u.pm * BM + rt; const int pn = u.pn; const float s = scr[rt];
        if (pn < 8) {
            const int col = pn * HALF + wc * 32 + 8 * fq; float o[8];
#pragma unroll
            for (int n = 0; n < 2; ++n)
#pragma unroll
                for (int j = 0; j < 4; ++j) o[n * 4 + j] = (s * v[0][n][j]) * (s * v[1][n][j]);
            u32x4 w; w.x = cvt_pk_bf16(o[0], o[1]); w.y = cvt_pk_bf16(o[2], o[3]); w.z = cvt_pk_bf16(o[4], o[5]); w.w = cvt_pk_bf16(o[6], o[7]);
            st16(Z + (size_t)row * D + col, w);
            int t, seq; float* cs;
            if (row < MP) { seq = row >> 12; t = (row & 4095) - (SEQ - 2); cs = dout + O_CONVP; } else { const int r2 = row - MP; seq = r2 >> 5; t = (r2 & 31) - (DSEQ - 2); cs = dout + O_CONVS; }
            if (t >= 0) { float* p = cs + ((size_t)seq * 2 + t) * D + col; *(f32x4*)p = (f32x4){o[0], o[1], o[2], o[3]}; *(f32x4*)(p + 4) = (f32x4){o[4], o[5], o[6], o[7]}; }
        } else {
#pragma unroll
            for (int bj = 0; bj < 2; ++bj) { const int cc = (pn & 3) * BM + bj * HALF + wc * 32 + 8 * fq; float o[8];
#pragma unroll
                for (int n = 0; n < 2; ++n)
#pragma unroll
                    for (int j = 0; j < 4; ++j) { const float x = s * v[bj][n][j]; o[n * 4 + j] = (pn >= 16) ? sigmoid_f(x) : x; }
                if (pn >= 16) { const u32x2 g8 = pack_unorm8(o); st8((pn < 20 ? SG8C : SG8S) + (size_t)row * D + cc, g8); }
                else { u32x4 w; w.x = cvt_pk_bf16(o[0], o[1]); w.y = cvt_pk_bf16(o[2], o[3]); w.z = cvt_pk_bf16(o[4], o[5]); w.w = cvt_pk_bf16(o[6], o[7]);
                    if (pn < 12) st16(BG + (size_t)row * D + cc, w);
                    else st16(U + ((size_t)(cc >> 4) * M + row) * 16 + (cc & 15), w); } }
        }
    }
    __device__ __forceinline__ void finish(const Unit&, LAS unsigned char*, int, int) const {}
};

struct EpiConvOut {
    static constexpr bool PERM = true, IDEM = true, RSCALE = false, FINAL = false; static constexpr int BATCH = 8;
    const unsigned char* G8; bf16_t* T;
    struct In { u32x2 g[2]; };
    __device__ __forceinline__ In load(const Unit& u, int ai, int m, int wr, int wc, int fr, int fq) const {
        const int row = u.pm * BM + ai * HALF + wr * 64 + m * 16 + fr, col0 = u.pn * BM + wc * 32 + 8 * fq; In in;
#pragma unroll
        for (int bj = 0; bj < 2; ++bj) in.g[bj] = *(const u32x2*)(G8 + (size_t)row * D + col0 + bj * HALF);
        return in;
    }
    __device__ __forceinline__ void rows(const Slice& v, const In& in, const Unit& u, int ai, int m, int wr, int wc, int fr, int fq, LAS float*) const {
        const int row = u.pm * BM + ai * HALF + wr * 64 + m * 16 + fr, col0 = u.pn * BM + wc * 32 + 8 * fq;
#pragma unroll
        for (int bj = 0; bj < 2; ++bj) { const u32x2 g = in.g[bj]; u32x4 w;
            w.x = cvt_pk_bf16(unorm8(g.x, 0) * v[bj][0][0], unorm8(g.x, 1) * v[bj][0][1]); w.y = cvt_pk_bf16(unorm8(g.x, 2) * v[bj][0][2], unorm8(g.x, 3) * v[bj][0][3]);
            w.z = cvt_pk_bf16(unorm8(g.y, 0) * v[bj][1][0], unorm8(g.y, 1) * v[bj][1][1]); w.w = cvt_pk_bf16(unorm8(g.y, 2) * v[bj][1][2], unorm8(g.y, 3) * v[bj][1][3]);
            st16(T + (size_t)row * D + col0 + bj * HALF, w); }
    }
    __device__ __forceinline__ void finish(const Unit&, LAS unsigned char*, int, int) const {}
};

struct EpiGlu {
    static constexpr bool PERM = true, IDEM = true, RSCALE = false, FINAL = false; static constexpr int BATCH = 8;
    const bf16_t* T0; const unsigned char* SG8; bf16_t* MG;
    struct In { u32x4 t; u32x2 g; };
    __device__ __forceinline__ In load(const Unit& u, int ai, int m, int wr, int wc, int fr, int fq) const {
        const int row = u.pm * BM + ai * HALF + wr * 64 + m * 16 + fr, col0 = u.pn * HALF + wc * 32 + 8 * fq; const size_t off = (size_t)row * D + col0;
        In in; in.t = *(const u32x4*)(T0 + off); in.g = *(const u32x2*)(SG8 + off); return in;
    }
    __device__ __forceinline__ void rows(const Slice& v, const In& in, const Unit& u, int ai, int m, int wr, int wc, int fr, int fq, LAS float*) const {
        const int row = u.pm * BM + ai * HALF + wr * 64 + m * 16 + fr, col0 = u.pn * HALF + wc * 32 + 8 * fq; const size_t off = (size_t)row * D + col0;
        const u32x4 t = in.t; const u32x2 g = in.g; float o[8];
        const float tv[8] = {bf_lo(t.x), bf_hi(t.x), bf_lo(t.y), bf_hi(t.y), bf_lo(t.z), bf_hi(t.z), bf_lo(t.w), bf_hi(t.w)};
        const float gv[8] = {unorm8(g.x, 0), unorm8(g.x, 1), unorm8(g.x, 2), unorm8(g.x, 3), unorm8(g.y, 0), unorm8(g.y, 1), unorm8(g.y, 2), unorm8(g.y, 3)};
#pragma unroll
        for (int n = 0; n < 2; ++n)
#pragma unroll
            for (int j = 0; j < 4; ++j) o[n * 4 + j] = tv[n * 4 + j] + gv[n * 4 + j] * v[0][n][j] * sigmoid_f(v[1][n][j]);
        u32x4 w; w.x = cvt_pk_bf16(o[0], o[1]); w.y = cvt_pk_bf16(o[2], o[3]); w.z = cvt_pk_bf16(o[4], o[5]); w.w = cvt_pk_bf16(o[6], o[7]);
        st16(MG + off, w);
    }
    __device__ __forceinline__ void finish(const Unit&, LAS unsigned char*, int, int) const {}
};

struct EpiFinal {
    static constexpr bool PERM = false, IDEM = false, RSCALE = false, FINAL = true;
    const bf16_t* base_b; float* Y; float* xs; unsigned* cnt; unsigned* cnt2; const float* g; float alpha;
    struct In { u32x2 w[2][2]; };
    struct Gv { f32x4 g[2][2]; };
    __device__ __forceinline__ In load(const Unit& u, int ai, int m, int wr, int wc, int fr, int fq) const {
        const int row = u.pm * BM + ai * HALF + wr * 64 + m * 16 + fr, col0 = u.pn * BM + wc * 32 + 4 * fq; const size_t off = (size_t)row * D + col0; In in;
#pragma unroll
        for (int bj = 0; bj < 2; ++bj)
#pragma unroll
            for (int n = 0; n < 2; ++n) in.w[bj][n] = *(const u32x2*)(base_b + off + bj * HALF + n * 16);
        return in;
    }
    __device__ __forceinline__ Gv load_g(const Unit& u, int wc, int fq) const { const int col0 = u.pn * BM + wc * 32 + 4 * fq; Gv r;
#pragma unroll
        for (int bj = 0; bj < 2; ++bj)
#pragma unroll
            for (int n = 0; n < 2; ++n) r.g[bj][n] = *(const f32x4*)(g + col0 + bj * HALF + n * 16);
        return r; }
    __device__ __forceinline__ void pass1(Slice& v, const In& in, const Unit& u, int ai, int m, int wr, int wc, int fr, int fq, LAS float* scr) const {
        const int rt = ai * HALF + wr * 64 + m * 16 + fr; float sq = 0.f;
#pragma unroll
        for (int bj = 0; bj < 2; ++bj)
#pragma unroll
            for (int n = 0; n < 2; ++n) { const u32x2 w = in.w[bj][n]; const f32x4 b = {bf_lo(w.x), bf_hi(w.x), bf_lo(w.y), bf_hi(w.y)};
                const f32x4 x = b + alpha * v[bj][n]; v[bj][n] = x; sq += (x[0] * x[0] + x[1] * x[1]) + (x[2] * x[2] + x[3] * x[3]); }
        sq += __shfl_xor(sq, 16); sq += __shfl_xor(sq, 32);
        if (fq == 0) scr[rt * 4 + wc] = sq;
    }
    __device__ __forceinline__ void exchange(const Unit& u, int sel, LAS unsigned char* lds, int tid) const {
        LAS float* scr = (LAS float*)(lds + SCR_OFF); const int wid = __builtin_amdgcn_readfirstlane(tid >> 6), lane = tid & 63;
        const bool mine = tid < 256 && (sel < 0 || (((tid >> 7) * 4 + ((tid >> 4) & 3)) == sel));
        unsigned* c = sel < 0 ? cnt + 64 * u.pm : cnt2 + 64 * ((u.pm - MP / BM) * 8 + sel);
        asm volatile("s_waitcnt lgkmcnt(0)" ::: "memory"); __builtin_amdgcn_s_barrier(); asm volatile("" ::: "memory");
        if (mine) { const f32x4 p = *(const LAS f32x4*)(scr + tid * 4); __hip_atomic_store((unsigned*)(xs + (size_t)(u.pm * BM + tid) * 4 + u.pn), __float_as_uint((p[0] + p[1]) + (p[2] + p[3])), __ATOMIC_RELAXED, __HIP_MEMORY_SCOPE_AGENT); }
        asm volatile("s_waitcnt vmcnt(0)" ::: "memory");
        if (lane == 0) __hip_atomic_fetch_add(c, 1u, __ATOMIC_RELAXED, __HIP_MEMORY_SCOPE_AGENT);
        if (wid == 0) { unsigned sp = 0; while ((unsigned)__builtin_amdgcn_readfirstlane(__hip_atomic_load(c, __ATOMIC_RELAXED, __HIP_MEMORY_SCOPE_AGENT)) < 32u) { __builtin_amdgcn_s_sleep(2); if (++sp > (1u << 22)) break; }
            __builtin_amdgcn_fence(__ATOMIC_ACQUIRE, "agent"); }
        asm volatile("s_waitcnt vmcnt(0) lgkmcnt(0)" ::: "memory"); __builtin_amdgcn_s_barrier(); asm volatile("" ::: "memory");
        if (mine) { const unsigned* sl = (const unsigned*)(xs + (size_t)(u.pm * BM + tid) * 4); float t = 0.f;
#pragma unroll
            for (int k = 0; k < 4; ++k) t += __uint_as_float(__hip_atomic_load(sl + k, __ATOMIC_RELAXED, __HIP_MEMORY_SCOPE_AGENT));
            scr[1024 + tid] = rsqrtf(t * (1.0f / D) + RMS_EPS); }
        asm volatile("s_waitcnt lgkmcnt(0)" ::: "memory"); __builtin_amdgcn_s_barrier(); asm volatile("" ::: "memory");
    }
    __device__ __forceinline__ void pass2(const Slice& v, const Gv& gv, const Unit& u, int ai, int m, int wr, int wc, int fr, int fq, const LAS float* scr) const {
        const int rt = ai * HALF + wr * 64 + m * 16 + fr, row = u.pm * BM + rt, col0 = u.pn * BM + wc * 32 + 4 * fq; const size_t off = (size_t)row * D + col0; const float s = scr[1024 + rt];
#pragma unroll
        for (int bj = 0; bj < 2; ++bj)
#pragma unroll
            for (int n = 0; n < 2; ++n) *(f32x4*)(Y + off + bj * HALF + n * 16) = v[bj][n] * s * gv.g[bj][n];
    }
};

template <class Epi>
__device__ __forceinline__ void run_epilogue(const Epi& E, const Acc& acc, const Unit& u, int wr, int wc, int fr, int fq, LAS unsigned char* lds, int tid, int par, bool has_next, int next_pm) {
    LAS float* scr = (LAS float*)(lds + SCR_OFF);
    LAS float* tab = scr + 1024 + par * 256;
    f32x4 nx = {1.f, 1.f, 1.f, 1.f};
    if constexpr (Epi::RSCALE) { if (has_next) nx = *(const f32x4*)(E.ss + (size_t)(next_pm * BM + (tid & 255)) * 4); }
    constexpr int NB = Epi::BATCH;
#pragma unroll
    for (int k0 = 0; k0 < 8; k0 += NB) { typename Epi::In in[NB];
#pragma unroll
        for (int k = 0; k < NB; ++k) in[k] = E.load(u, (k0 + k) >> 2, (k0 + k) & 3, wr, wc, fr, fq);
#pragma unroll
        for (int k = 0; k < NB; ++k) { const int ai = (k0 + k) >> 2, m = (k0 + k) & 3;
            const Slice v = {{acc[ai][0][m][0], acc[ai][0][m][1]}, {acc[ai][1][m][0], acc[ai][1][m][1]}}; E.rows(v, in[k], u, ai, m, wr, wc, fr, fq, Epi::RSCALE ? tab : scr); } }
    if (Epi::RSCALE && has_next) scr[1024 + (par ^ 1) * 256 + (tid & 255)] = rsqrtf(((nx[0] + nx[1]) + (nx[2] + nx[3])) * (1.0f / D) + RMS_EPS);
    E.finish(u, lds, tid, -1);
}
__device__ __forceinline__ void store_partial(u32x2* P, int ns, const Acc& acc, const Unit& u, int tid) {
    u32x2* p = P + ((size_t)(u.tidx * ns + u.part) * 32) * 512 + tid;
#pragma unroll
    for (int ai = 0; ai < 2; ++ai)
#pragma unroll
        for (int bj = 0; bj < 2; ++bj)
#pragma unroll
            for (int m = 0; m < 4; ++m)
#pragma unroll
                for (int n = 0; n < 2; ++n) { const f32x4 v = acc[ai][bj][m][n]; u32x2 w; w.x = cvt_pk_bf16(v[0], v[1]); w.y = cvt_pk_bf16(v[2], v[3]);
                    asm volatile("global_store_dwordx2 %0, %1, off sc1\n\ts_nop 1" :: "v"(&p[(size_t)((((ai * 2 + bj) * 4 + m) * 2 + n)) * 512]), "v"(w) : "memory"); }
}
template <bool SPLIT, class Epi, class Ord>
__device__ __forceinline__ void gemm_phase(LAS unsigned char* lds, const Gemm g, const Ord& S, const Epi& E, u32x2* P, unsigned* cnt) {
    const int tid = threadIdx.x, wid = __builtin_amdgcn_readfirstlane(tid >> 6), lane = tid & 63, wr = wid >> 2, wc = wid & 3, fr = lane & 15, fq = lane >> 4;
    const int K = g.K;
    unsigned voffA[2], voffB[2];
#pragma unroll
    for (int i = 0; i < 2; ++i) { int R, C; stage_rc(tid * 16 + i * 8192, R, C); const int Rb = Epi::PERM ? ((R & ~31) + perm32(R & 31)) : R;
        voffA[i] = (unsigned)R * g.a_rs + (unsigned)(C >> 4) * g.a_gs + (unsigned)(C & 15) * 2u; voffB[i] = (unsigned)(Rb * K + C) * 2u; }
    const size_t kstepA = (size_t)4 * g.a_gs, hstepA = (size_t)HALF * g.a_rs, tstepA = 2 * hstepA;
    const size_t kstepB = (size_t)(BK * 2), hstepB = (size_t)HALF * K * 2, tstepB = 2 * hstepB;
    const unsigned ldsw = (unsigned)wid * 1024u;
    const int aoff = lds_byte(wr * 64 + fr, fq * 8), boff = lds_byte(wc * 32 + fr, fq * 8);
#define PG8_SA(b, h) (((b) * 2 + (h)) * HTB)
#define PG8_SB(b, h) ((4 + (b) * 2 + (h)) * HTB)
#define PG8_STAGE(bufoff, gbase, voff) do { _Pragma("unroll") for (int _i = 0; _i < 2; ++_i) \
        __builtin_amdgcn_global_load_lds((const unsigned*)((const char*)(gbase) + (voff)[_i]), (LAS unsigned*)(lds + (bufoff) + ldsw + _i * 8192), 16, 0, 0); } while (0)
#define PG8_LDA(dst, b, h) do { _Pragma("unroll") for (int m = 0; m < 4; ++m) _Pragma("unroll") for (int k = 0; k < 2; ++k) dst[m][k] = *(const LAS bf16x8*)(lds + PG8_SA(b, h) + aoff + m * 2048 + k * 1024); } while (0)
#define PG8_LDB(dst, b, h) do { _Pragma("unroll") for (int n = 0; n < 2; ++n) _Pragma("unroll") for (int k = 0; k < 2; ++k) dst[n][k] = *(const LAS bf16x8*)(lds + PG8_SB(b, h) + boff + n * 2048 + k * 1024); } while (0)
#define PG8_MMA(ai, bj, At, Bt) do { __builtin_amdgcn_s_setprio(1); _Pragma("unroll") for (int m = 0; m < 4; ++m) _Pragma("unroll") for (int n = 0; n < 2; ++n) _Pragma("unroll") for (int k = 0; k < 2; ++k) \
        acc[ai][bj][m][n] = __builtin_amdgcn_mfma_f32_16x16x32_bf16(Bt[n][k], At[m][k], acc[ai][bj][m][n], 0, 0, 0); __builtin_amdgcn_s_setprio(0); } while (0)
#define PG8_WAIT_V(n) asm volatile("s_waitcnt vmcnt(" #n ")" ::: "memory")
#define PG8_WAIT_L(n) asm volatile("s_waitcnt lgkmcnt(" #n ")" ::: "memory")
#define PG8_BAR __builtin_amdgcn_s_barrier()
#define PG8_SCHED __builtin_amdgcn_sched_barrier(0)
    Unit cur, nxt; int ui = 0;
    if (!S.next(0, cur)) return;
    Acc acc;
#pragma unroll
    for (int a = 0; a < 2; ++a)
#pragma unroll
        for (int b = 0; b < 2; ++b)
#pragma unroll
            for (int m = 0; m < 4; ++m)
#pragma unroll
                for (int n = 0; n < 2; ++n) acc[a][b][m][n] = (f32x4){0.f, 0.f, 0.f, 0.f};
    bf16x8 At[4][2], B0[2][2], B1[2][2];
    if constexpr (Epi::RSCALE) { if (tid < 256) ((LAS float*)(lds + SCR_OFF))[1024 + tid] = rrms_of(E.ss, cur.pm * BM + tid); }
    const char* cA = (const char*)g.A + (size_t)cur.pm * tstepA + (size_t)cur.kt0 * kstepA; const char* cB = (const char*)g.Bt + (size_t)cur.pn * tstepB + (size_t)cur.kt0 * kstepB;
#if PG8_SP2
    PG8_STAGE(PG8_SB(0, 0), cB, voffB); PG8_STAGE(PG8_SB(0, 1), cB + hstepB, voffB); PG8_STAGE(PG8_SA(0, 0), cA, voffA); PG8_STAGE(PG8_SA(0, 1), cA + hstepA, voffA);
    if (wr == 1) PG8_BAR;
    PG8_WAIT_V(2); PG8_BAR;
    PG8_STAGE(PG8_SB(1, 0), cB + kstepB, voffB); PG8_STAGE(PG8_SA(1, 0), cA + kstepA, voffA); PG8_STAGE(PG8_SB(1, 1), cB + hstepB + kstepB, voffB);
    PG8_WAIT_V(6); PG8_BAR;
#else
    PG8_STAGE(PG8_SB(0, 0), cB, voffB); PG8_STAGE(PG8_SA(0, 0), cA, voffA); PG8_STAGE(PG8_SB(0, 1), cB + hstepB, voffB); PG8_STAGE(PG8_SA(0, 1), cA + hstepA, voffA);
    if (wr == 1) PG8_BAR;
    PG8_WAIT_V(4); PG8_BAR;
    PG8_STAGE(PG8_SB(1, 0), cB + kstepB, voffB); PG8_STAGE(PG8_SA(1, 0), cA + kstepA, voffA); PG8_STAGE(PG8_SB(1, 1), cB + hstepB + kstepB, voffB);
    PG8_WAIT_V(6); PG8_BAR;
#endif
    for (;;) {
#ifdef KDUP
        const bool has_next = S.next((ui + 1) >> 1, nxt); const bool do_epi = (ui & 1) != 0;
#else
        const bool has_next = S.next(ui + 1, nxt); const bool do_epi = true;
#endif
        const char* nA = has_next ? (const char*)g.A + (size_t)nxt.pm * tstepA + (size_t)nxt.kt0 * kstepA : cA; const char* nB = has_next ? (const char*)g.Bt + (size_t)nxt.pn * tstepB + (size_t)nxt.kt0 * kstepB : cB;
        const int nt = cur.nkt;
        for (int t = 0; t < nt; t += 2) {
            const bool last = (t == nt - 2);
            const char* a1 = cA + (size_t)(t + 1) * kstepA;
            const char* a2 = last ? nA : cA + (size_t)(t + 2) * kstepA; const char* b2 = last ? nB : cB + (size_t)(t + 2) * kstepB;
            const char* a3 = a2 + kstepA; const char* b3 = b2 + kstepB;
#if PG8_SP2
            PG8_LDB(B0, 0, 0); PG8_LDB(B1, 0, 1); PG8_SCHED; PG8_LDA(At, 0, 0); PG8_STAGE(PG8_SA(1, 1), a1 + hstepA, voffA);
            PG8_WAIT_V(8); PG8_WAIT_L(0); PG8_BAR; PG8_MMA(0, 0, At, B0); PG8_MMA(0, 1, At, B1); PG8_BAR; PG8_SCHED;
            PG8_LDA(At, 0, 1); PG8_STAGE(PG8_SB(0, 0), b2, voffB); PG8_STAGE(PG8_SB(0, 1), b2 + hstepB, voffB); PG8_STAGE(PG8_SA(0, 0), a2, voffA);
            PG8_WAIT_V(8); PG8_WAIT_L(0); PG8_BAR; PG8_MMA(1, 0, At, B0); PG8_MMA(1, 1, At, B1); PG8_BAR; PG8_SCHED;
            PG8_LDB(B0, 1, 0); PG8_LDB(B1, 1, 1); PG8_SCHED; PG8_LDA(At, 1, 0); PG8_STAGE(PG8_SA(0, 1), a2 + hstepA, voffA);
            PG8_WAIT_V(8); PG8_WAIT_L(0); PG8_BAR; PG8_MMA(0, 0, At, B0); PG8_MMA(0, 1, At, B1); PG8_BAR; PG8_SCHED;
            PG8_LDA(At, 1, 1); PG8_STAGE(PG8_SB(1, 0), b3, voffB); PG8_STAGE(PG8_SB(1, 1), b3 + hstepB, voffB); PG8_STAGE(PG8_SA(1, 0), a3, voffA);
            PG8_WAIT_V(8); PG8_WAIT_L(0); PG8_BAR; PG8_MMA(1, 0, At, B0); PG8_MMA(1, 1, At, B1); PG8_BAR; PG8_SCHED;
#else
            PG8_LDB(B0, 0, 0); PG8_SCHED; PG8_LDA(At, 0, 0); PG8_STAGE(PG8_SA(1, 1), a1 + hstepA, voffA);
            PG8_WAIT_L(8); PG8_BAR; PG8_WAIT_L(0); PG8_MMA(0, 0, At, B0); PG8_BAR; PG8_SCHED;
            PG8_LDB(B1, 0, 1); PG8_STAGE(PG8_SB(0, 0), b2, voffB);
            PG8_BAR; PG8_WAIT_L(0); PG8_MMA(0, 1, At, B1); PG8_BAR;
            PG8_LDA(At, 0, 1); PG8_STAGE(PG8_SA(0, 0), a2, voffA);
            PG8_BAR; PG8_WAIT_L(0); PG8_MMA(1, 0, At, B0); PG8_BAR; PG8_SCHED;
            PG8_STAGE(PG8_SB(0, 1), b2 + hstepB, voffB);
            PG8_WAIT_V(6); PG8_BAR; PG8_MMA(1, 1, At, B1); PG8_BAR;
            PG8_LDB(B0, 1, 0); PG8_SCHED; PG8_LDA(At, 1, 0); PG8_STAGE(PG8_SA(0, 1), a2 + hstepA, voffA);
            PG8_WAIT_L(8); PG8_BAR; PG8_WAIT_L(0); PG8_MMA(0, 0, At, B0); PG8_BAR; PG8_SCHED;
            PG8_LDB(B1, 1, 1); PG8_STAGE(PG8_SB(1, 0), b3, voffB);
            PG8_BAR; PG8_WAIT_L(0); PG8_MMA(0, 1, At, B1); PG8_BAR;
            PG8_LDA(At, 1, 1); PG8_STAGE(PG8_SA(1, 0), a3, voffA);
            PG8_BAR; PG8_WAIT_L(0); PG8_MMA(1, 0, At, B0); PG8_BAR; PG8_SCHED;
            PG8_STAGE(PG8_SB(1, 1), b3 + hstepB, voffB);
            PG8_WAIT_V(6); PG8_BAR; PG8_MMA(1, 1, At, B1); PG8_BAR;
#endif
        }
        if (wr == 0) PG8_BAR;
#ifdef KDUP
        if (do_epi) { _Pragma("unroll") for (int a_ = 0; a_ < 2; ++a_) _Pragma("unroll") for (int b_ = 0; b_ < 2; ++b_) _Pragma("unroll") for (int m_ = 0; m_ < 4; ++m_) _Pragma("unroll") for (int n_ = 0; n_ < 2; ++n_) acc[a_][b_][m_][n_] *= 0.5f; }
#endif
        if (!do_epi) {}
#ifdef EDUP
        else if (!SPLIT || cur.part < 0) { static_assert(!Epi::FINAL, "EDUP probe predates the fused final epilogue"); run_epilogue(E, acc, cur, wr, wc, fr, fq, lds, tid, ui & 1, false, 0); if (Epi::IDEM) { asm volatile("" ::: "memory"); run_epilogue(E, acc, cur, wr, wc, fr, fq, lds, tid, ui & 1, has_next, nxt.pm); } }
#else
        else if (!SPLIT || cur.part < 0) {
            if constexpr (Epi::FINAL) { LAS float* scr = (LAS float*)(lds + SCR_OFF);
                { typename Epi::In in[8];
#pragma unroll
                  for (int k = 0; k < 8; ++k) in[k] = E.load(cur, k >> 2, k & 3, wr, wc, fr, fq);
#pragma unroll
                  for (int k = 0; k < 8; ++k) { const int ai = k >> 2, m = k & 3; Slice v = {{acc[ai][0][m][0], acc[ai][0][m][1]}, {acc[ai][1][m][0], acc[ai][1][m][1]}}; E.pass1(v, in[k], cur, ai, m, wr, wc, fr, fq, scr);
                      acc[ai][0][m][0] = v[0][0]; acc[ai][0][m][1] = v[0][1]; acc[ai][1][m][0] = v[1][0]; acc[ai][1][m][1] = v[1][1]; } }
                const typename Epi::Gv gv = E.load_g(cur, wc, fq);
                E.exchange(cur, -1, lds, tid);
#pragma unroll
                for (int ai = 0; ai < 2; ++ai)
#pragma unroll
                    for (int m = 0; m < 4; ++m) { const Slice v = {{acc[ai][0][m][0], acc[ai][0][m][1]}, {acc[ai][1][m][0], acc[ai][1][m][1]}}; E.pass2(v, gv, cur, ai, m, wr, wc, fr, fq, scr); }
            } else run_epilogue(E, acc, cur, wr, wc, fr, fq, lds, tid, ui & 1, has_next, nxt.pm);
            S.after_unit(ui, tid);
        }
#endif
        else {
            store_partial(P, 8, acc, cur, tid);
            asm volatile("s_waitcnt vmcnt(0)" ::: "memory"); __syncthreads();
            if (tid == 0) { unsigned* c = cnt + 64 * cur.tidx;
                __hip_atomic_fetch_add(c, 1u, __ATOMIC_RELAXED, __HIP_MEMORY_SCOPE_AGENT);
                unsigned sp = 0; while (__hip_atomic_load(c, __ATOMIC_RELAXED, __HIP_MEMORY_SCOPE_AGENT) < 8u) { __builtin_amdgcn_s_sleep(1); if (++sp > (1u << 22)) break; } }
            __syncthreads();
            const int sel = cur.part, sai = sel >> 2, sm = sel & 3; LAS float* scr = (LAS float*)(lds + SCR_OFF);
            Slice v = {{{0.f, 0.f, 0.f, 0.f}, {0.f, 0.f, 0.f, 0.f}}, {{0.f, 0.f, 0.f, 0.f}, {0.f, 0.f, 0.f, 0.f}}};
            { u32x2 t[8][2][2];
#pragma unroll
              for (int pp = 0; pp < 8; ++pp) { const u32x2* p = P + ((size_t)(cur.tidx * 8 + pp) * 32) * 512 + tid;
#pragma unroll
                  for (int bj = 0; bj < 2; ++bj)
#pragma unroll
                      for (int n = 0; n < 2; ++n) { const unsigned long long q8 = __hip_atomic_load((const unsigned long long*)&p[(size_t)((((sai * 2 + bj) * 4 + sm) * 2 + n)) * 512], __ATOMIC_RELAXED, __HIP_MEMORY_SCOPE_AGENT);
                          t[pp][bj][n] = (u32x2){(unsigned)q8, (unsigned)(q8 >> 32)}; } }
#pragma unroll
              for (int pp = 0; pp < 8; ++pp)
#pragma unroll
                  for (int bj = 0; bj < 2; ++bj)
#pragma unroll
                      for (int n = 0; n < 2; ++n) { const u32x2 w = t[pp][bj][n]; v[bj][n] += (f32x4){bf_lo(w.x), bf_hi(w.x), bf_lo(w.y), bf_hi(w.y)}; } }
            Unit fu = cur; fu.part = -1;
            if constexpr (Epi::FINAL) { const typename Epi::In fin = E.load(fu, sai, sm, wr, wc, fr, fq); const typename Epi::Gv gv = E.load_g(fu, wc, fq); E.pass1(v, fin, fu, sai, sm, wr, wc, fr, fq, scr); E.exchange(fu, sel, lds, tid); E.pass2(v, gv, fu, sai, sm, wr, wc, fr, fq, scr); }
            else { const typename Epi::In fin = E.load(fu, sai, sm, wr, wc, fr, fq); E.rows(v, fin, fu, sai, sm, wr, wc, fr, fq, scr); E.finish(fu, lds, tid, sel); }
        }
        if (!has_next) break;
        if (do_epi) {
#pragma unroll
        for (int a = 0; a < 2; ++a)
#pragma unroll
            for (int b = 0; b < 2; ++b)
#pragma unroll
                for (int m = 0; m < 4; ++m)
#pragma unroll
                    for (int n = 0; n < 2; ++n) acc[a][b][m][n] = (f32x4){0.f, 0.f, 0.f, 0.f};
        }
        cur = nxt; cA = nA; cB = nB; ++ui;
        if (wr == 1) PG8_BAR;
    }
    PG8_WAIT_V(0);
    PG8_BAR;
#undef PG8_SA
#undef PG8_SB
#undef PG8_STAGE
#undef PG8_LDA
#undef PG8_LDB
#undef PG8_MMA
#undef PG8_WAIT_V
#undef PG8_WAIT_L
#undef PG8_BAR
#undef PG8_SCHED
}
}

constexpr size_t MiB = 1u << 20;
constexpr size_t WS_CTL = 0, CTL_ZERO_BYTES = 128 * 1024;
constexpr size_t WS_SS = 1 * MiB;
constexpr size_t SS_BYTES = (size_t)M * 4 * 4;
constexpr size_t WS_W1T = 3 * MiB, WS_W3T = 7 * MiB, WS_TOEP = 11 * MiB, WS_LAM = 12 * MiB;
constexpr size_t WS_WGU = 13 * MiB;
constexpr size_t WS_WD = 24 * MiB;
constexpr size_t WS_WIN = WS_WD + (size_t)D * FF * 2;
constexpr size_t WS_WCO = WS_WIN + (size_t)NIN * D * 2;
constexpr size_t WS_WGLU = WS_WCO + (size_t)D * D * 2;
constexpr size_t WS_WO = WS_WGLU + (size_t)2 * D * D * 2;
constexpr size_t WS_XA = 50 * MiB;
constexpr size_t SLOT = (size_t)M * D * 2;
constexpr size_t WS_R = 84 * MiB;
constexpr size_t WS_END = WS_R + 5 * SLOT;
static_assert(WS_WO + (size_t)D * D * 2 <= WS_XA && WS_XA + SLOT <= WS_R && WS_END <= 256 * MiB && (size_t)M * FF * 2 <= 4 * SLOT, "d_ws map");
constexpr int CW_BAR = 1024;
constexpr int CW_FIN = 16384;
constexpr int CW_ZF = 4992;
constexpr int CW_CNT = 5120;

#define XB_TMO      128
#define XB_XCNT(j)  (256  + 64 * (j))
#define XB_XSUB(j)  (1280 + 64 * (j))
#define XB_XGEN(j)  (2304 + 64 * (j))
#define XB_TOP      3328
#define XB_TOPGEN   3392
#define XCD_BAR_WORDS 3456
#define XB_SPIN_CAP (1u << 20)
__device__ __forceinline__ unsigned xb_ld(unsigned* p)              { return __hip_atomic_load(p, __ATOMIC_RELAXED, __HIP_MEMORY_SCOPE_AGENT); }
__device__ __forceinline__ unsigned xb_add(unsigned* p, unsigned v) { return __hip_atomic_fetch_add(p, v, __ATOMIC_RELAXED, __HIP_MEMORY_SCOPE_AGENT); }
__device__ __forceinline__ unsigned xb_xcc_id() { return (unsigned)__builtin_amdgcn_s_getreg((3 << 11) | 20) & 0xFu; }
#define XB_SPIN(cond, bar) do { unsigned _sp = 0; while (cond) { __builtin_amdgcn_s_sleep(1); \
    if ((++_sp & 255u) == 0u) { if (xb_ld(&(bar)[XB_TMO])) break; if (_sp > XB_SPIN_CAP) { atomicAdd(&(bar)[XB_TMO], 1u); break; } } } } while (0)
struct XcdBarrier { unsigned* bar; unsigned x; volatile LAS unsigned* st; };
__device__ __forceinline__ XcdBarrier xcd_barrier_post(unsigned* bar, volatile LAS unsigned* st) {
    XcdBarrier b; b.bar = bar; b.x = xb_xcc_id(); b.st = st;
    if (threadIdx.x == 0) (void)xb_add(&bar[XB_XCNT(b.x)], 1u);
    return b;
}
__device__ __forceinline__ void xcd_barrier_complete(unsigned* bar, unsigned x, unsigned& nloc, unsigned& nx) {
    const unsigned G = gridDim.x * gridDim.y * gridDim.z;
    unsigned sum, cnt, mine, sp = 0u;
    for (;;) {
        sum = 0u; cnt = 0u; mine = 0u;
#pragma unroll
        for (unsigned j = 0; j < 16; ++j) { const unsigned c = xb_ld(&bar[XB_XCNT(j)]); sum += c; cnt += (c > 0u) ? 1u : 0u; mine = (j == x) ? c : mine; }
        if (sum == G) break;
        __builtin_amdgcn_s_sleep(1);
        if ((++sp & 255u) == 0u) { if (xb_ld(&bar[XB_TMO])) break; if (sp > XB_SPIN_CAP) { atomicAdd(&bar[XB_TMO], 1u); break; } }
    }
    nloc = mine > 0u ? mine : 1u; nx = cnt > 0u ? cnt : 1u;
}
__device__ __forceinline__ void xcd_barrier(const XcdBarrier& b) {
    asm volatile("s_waitcnt vmcnt(0)" ::: "memory");
    __syncthreads();
    if (threadIdx.x == 0) {
        unsigned* bar = b.bar;
        __builtin_amdgcn_s_waitcnt(0);
        unsigned nloc = b.st[0], nx = b.st[1];
        if (nloc == 0u) { xcd_barrier_complete(bar, b.x, nloc, nx); b.st[0] = nloc; b.st[1] = nx; }
        const unsigned old = xb_add(&bar[XB_XSUB(b.x)], 1u);
        const unsigned gen = old / nloc;
        if (old + 1u == (gen + 1u) * nloc) {
            __builtin_amdgcn_fence(__ATOMIC_RELEASE, "agent");
            asm volatile("s_waitcnt vmcnt(0)" ::: "memory");
            const unsigned og = xb_add(&bar[XB_TOP], 1u);
            const unsigned tg = og / nx;
            if (og + 1u == (tg + 1u) * nx) xb_add(&bar[XB_TOPGEN], 1u);
            else XB_SPIN(xb_ld(&bar[XB_TOPGEN]) == tg, bar);
            __builtin_amdgcn_fence(__ATOMIC_ACQUIRE, "agent");
            xb_add(&bar[XB_XGEN(b.x)], 1u);
            asm volatile("s_waitcnt vmcnt(0)" ::: "memory");
        } else {
            XB_SPIN(xb_ld(&bar[XB_XGEN(b.x)]) == gen, bar);
            __builtin_amdgcn_fence(__ATOMIC_ACQUIRE, "agent");
            asm volatile("s_waitcnt vmcnt(0)" ::: "memory");
        }
    }
    __syncthreads();
}

struct Args {
    const float* in[28]; float* out; unsigned char* ws; int ph_lo, ph_hi;
};
#define LDS_WAIT() asm volatile("s_waitcnt lgkmcnt(0)" ::: "memory")

__device__ __forceinline__ float wave_sum(float v) {
#pragma unroll
    for (int o = 1; o < 64; o <<= 1) v += __shfl_xor(v, o);
    return v;
}

__device__ __forceinline__ void transpose_item(const float* W, int N, bf16_t* WT, int K, int drow0, const float* gain, LAS float* scr, int k0, int n0, int lane) {
    const int l15 = lane & 15, q = lane >> 4;
    f32x4 v[16];
#pragma unroll
    for (int i = 0; i < 16; ++i) v[i] = *(const f32x4*)(W + (size_t)(k0 + 4 * i + q) * N + n0 + 4 * l15);
#pragma unroll
    for (int i = 0; i < 16; ++i) { const int kk = 4 * i + q; const float gsc = gain ? gain[k0 + kk] : 1.0f; LAS float* d = scr + kk * 65 + 4 * l15;
        d[0] = v[i][0] * gsc; d[1] = v[i][1] * gsc; d[2] = v[i][2] * gsc; d[3] = v[i][3] * gsc; }
    LDS_WAIT(); asm volatile("" ::: "memory");
    const int c = lane & 7;
#pragma unroll
    for (int j = 0; j < 8; ++j) { const int n = (lane >> 3) + 8 * j; const LAS float* sp = scr + (8 * c) * 65 + n;
        u32x4 o; o.x = cvt_pk_bf16(sp[0 * 65], sp[1 * 65]); o.y = cvt_pk_bf16(sp[2 * 65], sp[3 * 65]); o.z = cvt_pk_bf16(sp[4 * 65], sp[5 * 65]); o.w = cvt_pk_bf16(sp[6 * 65], sp[7 * 65]);
        *(u32x4*)(WT + (size_t)(drow0 + n) * K + k0 + 8 * c) = o; }
    LDS_WAIT(); asm volatile("" ::: "memory");
}
__device__ __forceinline__ int pair_lo(int n) { return 256 * (n >> 7) + (n & 127); }
__device__ __forceinline__ int pair_hi(int n) { return 256 * (n >> 7) + 128 + (n & 127); }
constexpr int IT_GU = (D / 64) * (FF / 64), IT_DN = (FF / 64) * (D / 64), IT_FFN = 2 * IT_GU + IT_DN;
__device__ __forceinline__ void conv_ffn_item(int r, const float* wg, const float* wu, const float* wd, const float* gain, bf16_t* WGU, bf16_t* WDt, LAS float* scr, int lane) {
    if (r < IT_GU) { const int kb = r / (FF / 64), nb = r % (FF / 64); transpose_item(wg, FF, WGU, D, pair_lo(64 * nb), gain, scr, 64 * kb, 64 * nb, lane); return; } r -= IT_GU;
    if (r < IT_GU) { const int kb = r / (FF / 64), nb = r % (FF / 64); transpose_item(wu, FF, WGU, D, pair_hi(64 * nb), gain, scr, 64 * kb, 64 * nb, lane); return; } r -= IT_GU;
    { const int kb = r / (D / 64), nb = r % (D / 64); transpose_item(wd, D, WDt, FF, 64 * nb, nullptr, scr, 64 * kb, 64 * nb, lane); }
}

constexpr int IT_WIN = (D / 64) * (NIN / 64), IT_CO = (D / 64) * (D / 64), IT_GLU = (D / 64) * (2 * D / 64), IT_O = IT_CO;
constexpr int X3_FFN2 = 1536, X5_FFN2 = 512;
constexpr int ITB_FFN2 = IT_FFN, ITB_WIN = 2 * IT_FFN, ITB_CO = ITB_WIN + IT_WIN, ITB_GLU = ITB_CO + IT_CO, ITB_O = ITB_GLU + IT_GLU, ITB_END = ITB_O + IT_O;
__device__ __forceinline__ void conv_item(const Args& a, LAS float* scr, int it, int lane) {
    unsigned char* ws = a.ws;
    bf16_t* WGU = (bf16_t*)(ws + WS_WGU); bf16_t* WDt = (bf16_t*)(ws + WS_WD); bf16_t* WIN = (bf16_t*)(ws + WS_WIN); bf16_t* WCO = (bf16_t*)(ws + WS_WCO); bf16_t* WGLU = (bf16_t*)(ws + WS_WGLU); bf16_t* WOt = (bf16_t*)(ws + WS_WO);
    bf16_t* WGU1 = (bf16_t*)a.out; bf16_t* WD1 = WGU1 + (size_t)2 * FF * D;
    int r = it;
    if (r < IT_FFN) { conv_ffn_item(r, a.in[6], a.in[7], a.in[8], a.in[5], WGU1, WD1, scr, lane); return; } r -= IT_FFN;
    if (r < IT_FFN) { conv_ffn_item(r, a.in[24], a.in[25], a.in[26], a.in[23], WGU, WDt, scr, lane); return; } r -= IT_FFN;
    if (r < IT_WIN) { const int kb = r / (NIN / 64), nb = r % (NIN / 64), n0 = 64 * nb; const int dr = n0 < 1024 ? pair_lo(n0) : (n0 < 2048 ? pair_hi(n0 - 1024) : n0);
        transpose_item(a.in[10], NIN, WIN, D, dr, a.in[9], scr, 64 * kb, n0, lane); return; } r -= IT_WIN;
    if (r < IT_CO) { const int kb = r / (D / 64), nb = r % (D / 64); transpose_item(a.in[12], D, WCO, D, 64 * nb, nullptr, scr, 64 * kb, 64 * nb, lane); return; } r -= IT_CO;
    if (r < IT_GLU) { const int kb = r / (2 * D / 64), nb = r % (2 * D / 64), n0 = 64 * nb; const int dr = n0 < 1024 ? pair_lo(n0) : pair_hi(n0 - 1024);
        transpose_item(a.in[21], 2 * D, WGLU, D, dr, nullptr, scr, 64 * kb, n0, lane); return; } r -= IT_GLU;
    { const int kb = r / (D / 64), nb = r % (D / 64); transpose_item(a.in[22], D, WOt, D, 64 * nb, nullptr, scr, 64 * kb, 64 * nb, lane); }
}
__device__ __forceinline__ void conv_range(const Args& a, LAS unsigned char* lds, int lo, int hi, int idx, int n, int wave, int lane) {
    LAS float* scr = (LAS float*)(lds + wave * 16896);
    for (int it = lo + idx; it < hi; it += n) conv_item(a, scr, it, lane);
}
__device__ __forceinline__ void conv_range2(const Args& a, LAS unsigned char* lds, int lo1, int hi1, int lo2, int hi2, int idx, int n, int wave, int lane) {
    LAS float* scr = (LAS float*)(lds + wave * 16896); const int n1 = hi1 - lo1, nt = n1 + (hi2 - lo2);
    for (int v = idx; v < nt; v += n) conv_item(a, scr, v < n1 ? lo1 + v : lo2 + (v - n1), lane);
}

typedef float cplx __attribute__((ext_vector_type(2)));
#define CX(a, b) ((cplx){(a), (b)})
__device__ __forceinline__ cplx cmul(cplx a, cplx b) { return CX(a.x * b.x - a.y * b.y, a.x * b.y + a.y * b.x); }
__device__ __forceinline__ cplx cfma(cplx a, cplx b, cplx c) { return CX(fmaf(a.x, b.x, fmaf(-a.y, b.y, c.x)), fmaf(a.x, b.y, fmaf(a.y, b.x, c.y))); }

__device__ __forceinline__ void ssm_tables_job(const Args& a, LAS unsigned char* lds, int g, int part, int tid) {
    LAS cplx* pw = (LAS cplx*)lds;
    LAS cplx* bb = pw + 17 * 64;
    LAS cplx* cc = bb + 64 * 16;
    LAS float* kt = (LAS float*)(cc + 16 * 64);
    const float* lam_re = a.in[13] + g * NP; const float* lam_im = a.in[14] + g * NP; const float stepv = expf(a.in[15][g]);
    const float* b_re = a.in[16] + (size_t)g * NP * 16; const float* b_im = a.in[17] + (size_t)g * NP * 16;
    const float* c_re = a.in[18] + (size_t)g * 16 * NP; const float* c_im = a.in[19] + (size_t)g * 16 * NP; const float* dsk = a.in[20] + g * 16;
    unsigned char* ws = a.ws;
    for (int idx = tid; idx < 17 * 64; idx += 512) { const int tau = idx >> 6, p = idx & 63;
        const float zr = (float)tau * stepv * lam_re[p]; const double zt = (double)tau * (double)stepv * (double)lam_im[p] * 0.15915494309189535;
        const float rt = (float)(zt - rint(zt));
        const float mag = __builtin_amdgcn_exp2f(zr * 1.4426950409f); pw[idx] = CX(mag * __builtin_amdgcn_cosf(rt), mag * __builtin_amdgcn_sinf(rt)); }
    for (int idx = tid; idx < 64 * 16; idx += 512) { const int p = idx >> 4;
        const float lr = lam_re[p], li = lam_im[p], zr = stepv * lr; const double zt = (double)stepv * (double)li * 0.15915494309189535; const float rt = (float)(zt - rint(zt));
        const float ex1 = zr * (1.0f + zr * (0.5f + zr * (0.16666667f + zr * (0.041666668f + zr * 0.0083333338f))));
        const float sn = __builtin_amdgcn_sinf(rt), cs = __builtin_amdgcn_cosf(rt), sh = __builtin_amdgcn_sinf(0.5f * rt);
        const float nr = ex1 * cs - 2.0f * sh * sh, ni = (ex1 + 1.0f) * sn;
        const float den = 1.0f / (lr * lr + li * li); const cplx q = CX((nr * lr + ni * li) * den, (ni * lr - nr * li) * den);
        bb[idx] = cmul(q, CX(b_re[idx], b_im[idx])); }
    for (int idx = tid; idx < 16 * 64; idx += 512) cc[idx] = CX(c_re[idx], c_im[idx]);
    __syncthreads();
    {
        bf16_t* W1T = (bf16_t*)(ws + WS_W1T) + (size_t)g * 32768;
        for (int o8 = part * 1024 + tid; o8 < part * 1024 + 1024; o8 += 512) { const int lane = o8 & 63, nt = (o8 >> 6) & 7, ks = o8 >> 9; const int n = nt * 16 + (lane & 15), p = n & 63, isim = n >> 6; float v[8];
#pragma unroll
            for (int jj = 0; jj < 8; ++jj) { const int kk = ks * 32 + 8 * (lane >> 4) + jj, j = kk >> 4, c1 = kk & 15; const cplx pr = cmul(pw[(15 - j) * 64 + p], bb[p * 16 + c1]); v[jj] = isim ? pr.y : pr.x; }
            u32x4 w; w.x = cvt_pk_bf16(v[0], v[1]); w.y = cvt_pk_bf16(v[2], v[3]); w.z = cvt_pk_bf16(v[4], v[5]); w.w = cvt_pk_bf16(v[6], v[7]);
            *(u32x4*)(W1T + (size_t)o8 * 8) = w; }
        bf16_t* W3T = (bf16_t*)(ws + WS_W3T) + (size_t)g * 32768;
        for (int o8 = part * 1024 + tid; o8 < part * 1024 + 1024; o8 += 512) { const int lane = o8 & 63, i = (o8 >> 6) & 15, ks = o8 >> 10; const int c = lane & 15; float v[8];
#pragma unroll
            for (int jj = 0; jj < 8; ++jj) { const int k = ks * 32 + 8 * (lane >> 4) + jj, p = k & 63, isim = k >> 6; const cplx cl = cmul(cc[c * 64 + p], pw[(i + 1) * 64 + p]); v[jj] = isim ? -cl.y : cl.x; }
            u32x4 w; w.x = cvt_pk_bf16(v[0], v[1]); w.y = cvt_pk_bf16(v[2], v[3]); w.z = cvt_pk_bf16(v[4], v[5]); w.w = cvt_pk_bf16(v[6], v[7]);
            *(u32x4*)(W3T + (size_t)o8 * 8) = w; }
        float* KT = (float*)(ws + WS_TOEP) + (size_t)g * 4096;
        for (int idx = part * 1024 + tid; idx < part * 1024 + 1024; idx += 512) { const int tau = idx >> 8, c = (idx >> 4) & 15, c1 = idx & 15; float sa = 0.f, sb = 0.f;
#pragma unroll 8
            for (int p = 0; p < 64; p += 2) { const cplx t0 = cmul(cc[c * 64 + p], pw[tau * 64 + p]), b0 = bb[p * 16 + c1], t1 = cmul(cc[c * 64 + p + 1], pw[tau * 64 + p + 1]), b1 = bb[(p + 1) * 16 + c1];
                sa += t0.x * b0.x - t0.y * b0.y; sb += t1.x * b1.x - t1.y * b1.y; }
            float sv = sa + sb; if (tau == 0 && c == c1) sv += dsk[c];
            KT[idx] = sv; }
        if (part == 0 && tid < 64) ((cplx*)(ws + WS_LAM))[g * 64 + tid] = pw[16 * 64 + tid];
    }
    __syncthreads();
}

constexpr int L_US = 0, L_SL = 67584, L_SIN = 101376, L_TOEP = 118784, L_ASEG = 135168, L_CARRY = 139264;
struct SsmFrags { bf16x8 w1[8]; bf16x8 w3[2][4]; cplx lam; };
#define LBAR() do { asm volatile("s_waitcnt lgkmcnt(0)" ::: "memory"); __builtin_amdgcn_s_barrier(); asm volatile("" ::: "memory"); } while (0)
template <bool SAMPLE>
__device__ __forceinline__ void ssm_tile(const Args& a, LAS unsigned char* lds, int g, int row0, int tile, bool first, bool last, int seq, const SsmFrags& F, bool has_next_tile, int tid, bf16_t* Yg) {
    const int wid = __builtin_amdgcn_readfirstlane(tid >> 6), lane = tid & 63, l15 = lane & 15, q = lane >> 4;
    unsigned char* ws = a.ws;
    bf16_t* Ug = (bf16_t*)(ws + WS_R + 2 * SLOT) + ((size_t)g * M + row0) * 16;
    const int ub = L_US + (tile & 1) * 33792, ubn = L_US + ((tile + 1) & 1) * 33792;
    u32x4 pf[4];
    if (has_next_tile) {
#pragma unroll
        for (int k = 0; k < 4; ++k) pf[k] = ((const u32x4*)(Ug + 16384))[tid + 512 * k]; }
#pragma unroll
    for (int rb = 0; rb < 4; ++rb) { f32x4 acc = {0.f, 0.f, 0.f, 0.f};
#pragma unroll
        for (int ks = 0; ks < 8; ++ks) { const bf16x8 av = *(const LAS bf16x8*)(lds + ub + (rb * 16 + l15) * 528 + ks * 64 + q * 16); acc = __builtin_amdgcn_mfma_f32_16x16x32_bf16(F.w1[ks], av, acc, 0, 0, 0); }
        *(LAS f32x4*)(lds + L_SL + ((rb * 16 + l15) * 132 + wid * 16 + q * 4) * 4) = acc; }
    LBAR();
    {
        const int p = lane, seg = wid; const LAS float* Sl = (const LAS float*)(lds + L_SL); LAS bf16_t* Sin = (LAS bf16_t*)(lds + L_SIN);
        const cplx L1 = F.lam;
        if (!SAMPLE) {
            LAS cplx* Aseg = (LAS cplx*)(lds + L_ASEG); LAS cplx* carry = (LAS cplx*)(lds + L_CARRY);
            cplx sv[8];
#pragma unroll
            for (int c = 0; c < 8; ++c) { const int ch = seg * 8 + c; sv[c] = CX(Sl[ch * 132 + p], Sl[ch * 132 + 64 + p]); }
            cplx acc = CX(0.f, 0.f);
#pragma unroll
            for (int c = 0; c < 8; ++c) acc = cfma(L1, acc, sv[c]);
            Aseg[seg * 64 + p] = acc;
            LBAR();
            const cplx L2 = cmul(L1, L1), L4 = cmul(L2, L2), L8 = cmul(L4, L4);
            cplx x = first ? CX(0.f, 0.f) : carry[(tile & 1) * 64 + p];
            for (int s = 0; s < seg; ++s) x = cfma(L8, x, Aseg[s * 64 + p]);
#pragma unroll
            for (int c = 0; c < 8; ++c) { const int ch = seg * 8 + c; Sin[ch * 136 + p] = (bf16_t)(cvt_pk_bf16(x.x, 0.f) & 0xffffu); Sin[ch * 136 + 64 + p] = (bf16_t)(cvt_pk_bf16(x.y, 0.f) & 0xffffu);
                x = cfma(L1, x, sv[c]); }
            if (seg == 7) { carry[((tile + 1) & 1) * 64 + p] = x;
                if (last) { a.out[O_SREP + ((size_t)seq * NG + g) * NP + p] = x.x; a.out[O_SIMP + ((size_t)seq * NG + g) * NP + p] = x.y; } }
        } else {
#pragma unroll
            for (int sq = 0; sq < 4; ++sq) { const int s = seg * 4 + sq; const size_t so = ((size_t)s * NG + g) * NP + p;
                cplx x = CX(a.in[3][so], a.in[4][so]);
#pragma unroll
                for (int c = 0; c < 2; ++c) { const int ch = 2 * s + c; Sin[ch * 136 + p] = (bf16_t)(cvt_pk_bf16(x.x, 0.f) & 0xffffu); Sin[ch * 136 + 64 + p] = (bf16_t)(cvt_pk_bf16(x.y, 0.f) & 0xffffu);
                    x = cfma(L1, x, CX(Sl[ch * 132 + p], Sl[ch * 132 + 64 + p])); }
                a.out[O_SRES + so] = x.x; a.out[O_SIMS + so] = x.y; }
        }
    }
    LBAR();
    {
        f32x4 acc[2][4];
#pragma unroll
        for (int t2 = 0; t2 < 2; ++t2)
#pragma unroll
            for (int rb = 0; rb < 4; ++rb) acc[t2][rb] = (f32x4){0.f, 0.f, 0.f, 0.f};
#pragma unroll
        for (int ks = 0; ks < 4; ++ks)
#pragma unroll
            for (int rb = 0; rb < 4; ++rb) { const bf16x8 av = *(const LAS bf16x8*)(lds + L_SIN + (rb * 16 + l15) * 272 + ks * 64 + q * 16);
                acc[0][rb] = __builtin_amdgcn_mfma_f32_16x16x32_bf16(F.w3[0][ks], av, acc[0][rb], 0, 0, 0); acc[1][rb] = __builtin_amdgcn_mfma_f32_16x16x32_bf16(F.w3[1][ks], av, acc[1][rb], 0, 0, 0); }
#pragma unroll
        for (int t2 = 0; t2 < 2; ++t2) { const int i = t2 ? 15 - wid : wid; const int ns = (i >> 1) + 1;
            bf16x8 bfc = *(const LAS bf16x8*)(lds + L_TOEP + (i * 64 + lane) * 16); bf16x8 avc[4];
#pragma unroll
            for (int rb = 0; rb < 4; ++rb) avc[rb] = *(const LAS bf16x8*)(lds + ub + (rb * 16 + l15) * 528 + q * 16);
            for (int s2 = 0; s2 < ns; ++s2) { const int sn = (s2 + 1 < ns) ? s2 + 1 : s2;
                const bf16x8 bfn = *(const LAS bf16x8*)(lds + L_TOEP + ((i - 2 * sn) * 64 + lane) * 16); bf16x8 avn[4];
#pragma unroll
                for (int rb = 0; rb < 4; ++rb) avn[rb] = *(const LAS bf16x8*)(lds + ub + (rb * 16 + l15) * 528 + sn * 64 + q * 16);
#pragma unroll
                for (int rb = 0; rb < 4; ++rb) acc[t2][rb] = __builtin_amdgcn_mfma_f32_16x16x32_bf16(bfc, avc[rb], acc[t2][rb], 0, 0, 0);
                bfc = bfn;
#pragma unroll
                for (int rb = 0; rb < 4; ++rb) avc[rb] = avn[rb]; }
#pragma unroll
            for (int rb = 0; rb < 4; ++rb) { u32x2 w; w.x = cvt_pk_bf16(gelu_tanh_f(acc[t2][rb][0]), gelu_tanh_f(acc[t2][rb][1])); w.y = cvt_pk_bf16(gelu_tanh_f(acc[t2][rb][2]), gelu_tanh_f(acc[t2][rb][3]));
                *(LAS u32x2*)(lds + L_SL + (rb * 16 + l15) * 528 + i * 32 + q * 8) = w; } }
    }
    LBAR();
#pragma unroll
    for (int k = 0; k < 4; ++k) { const int i = tid + 512 * k; const u32x4 v = *(const LAS u32x4*)(lds + L_SL + (i >> 5) * 528 + (i & 31) * 16); ((u32x4*)Yg)[i] = v; }
    if (has_next_tile) {
#pragma unroll
        for (int k = 0; k < 4; ++k) { const int i = tid + 512 * k; *(LAS u32x4*)(lds + ubn + (i >> 5) * 528 + (i & 31) * 16) = pf[k]; } }
    LBAR();
}
__device__ __forceinline__ void ssm_item_begin(const Args& a, LAS unsigned char* lds, int g, int row0, SsmFrags& F, int tid) {
    const int wid = __builtin_amdgcn_readfirstlane(tid >> 6), lane = tid & 63;
    unsigned char* ws = a.ws;
    const bf16_t* W1T = (const bf16_t*)(ws + WS_W1T) + (size_t)g * 32768; const bf16_t* W3T = (const bf16_t*)(ws + WS_W3T) + (size_t)g * 32768;
    const bf16_t* Ug = (const bf16_t*)(ws + WS_R + 2 * SLOT) + ((size_t)g * M + row0) * 16;
    u32x4 uv[4]; f32x4 ka[2][2];
#pragma unroll
    for (int k = 0; k < 4; ++k) uv[k] = ((const u32x4*)Ug)[tid + 512 * k];
    const float* KT = (const float*)(ws + WS_TOEP) + (size_t)g * 4096;
#pragma unroll
    for (int k = 0; k < 2; ++k) { const int o8 = tid + 512 * k, ln = o8 & 63, d = o8 >> 6, qq = ln >> 4, dd = d - (qq >> 1); const float* src = KT + (dd < 0 ? 0 : dd) * 256 + (ln & 15) * 16 + 8 * (qq & 1);
        ka[k][0] = *(const f32x4*)src; ka[k][1] = *(const f32x4*)(src + 4); if (dd < 0) { ka[k][0] = (f32x4){0.f, 0.f, 0.f, 0.f}; ka[k][1] = (f32x4){0.f, 0.f, 0.f, 0.f}; } }
#pragma unroll
    for (int ks = 0; ks < 8; ++ks) F.w1[ks] = *(const bf16x8*)(W1T + ((size_t)(ks * 8 + wid) * 64 + lane) * 8);
#pragma unroll
    for (int t2 = 0; t2 < 2; ++t2) { const int i = t2 ? 15 - wid : wid;
#pragma unroll
        for (int ks = 0; ks < 4; ++ks) F.w3[t2][ks] = *(const bf16x8*)(W3T + ((size_t)(ks * 16 + i) * 64 + lane) * 8); }
    F.lam = ((const cplx*)(ws + WS_LAM))[g * 64 + lane];
#pragma unroll
    for (int k = 0; k < 4; ++k) { const int i = tid + 512 * k; *(LAS u32x4*)(lds + L_US + (i >> 5) * 528 + (i & 31) * 16) = uv[k]; }
#pragma unroll
    for (int k = 0; k < 2; ++k) { u32x4 w; w.x = cvt_pk_bf16(ka[k][0][0], ka[k][0][1]); w.y = cvt_pk_bf16(ka[k][0][2], ka[k][0][3]); w.z = cvt_pk_bf16(ka[k][1][0], ka[k][1][1]); w.w = cvt_pk_bf16(ka[k][1][2], ka[k][1][3]);
        *(LAS u32x4*)(lds + L_TOEP + (tid + 512 * k) * 16) = w; }
    LDS_WAIT(); __syncthreads();
}

typedef float f32x8 __attribute__((ext_vector_type(8)));
__device__ __forceinline__ f32x8 bf8_to_f32(u32x4 v) { return (f32x8){bf_lo(v.x), bf_hi(v.x), bf_lo(v.y), bf_hi(v.y), bf_lo(v.z), bf_hi(v.z), bf_lo(v.w), bf_hi(v.w)}; }
__device__ __forceinline__ f32x8 ld_f32x8(const float* p) { const f32x4 a = *(const f32x4*)p, b = *(const f32x4*)(p + 4); return (f32x8){a[0], a[1], a[2], a[3], b[0], b[1], b[2], b[3]}; }
template <int NR>
__device__ __forceinline__ void conv_rows(const float* cstate, const bf16_t* Z, const bf16_t* BG, bf16_t* ZC, int r0, int c0, f32x8 w0, f32x8 w1, f32x8 w2, f32x8& z1, f32x8& z2) {
    u32x4 zv[NR], bv[NR];
#pragma unroll
    for (int rr = 0; rr < NR; ++rr) { zv[rr] = *(const u32x4*)(Z + (size_t)(r0 + rr) * D + c0); bv[rr] = *(const u32x4*)(BG + (size_t)(r0 + rr) * D + c0); }
#pragma unroll
    for (int rr = 0; rr < NR; ++rr) { const int row = r0 + rr;
        const bool st = (row < MP) ? ((row & 4095) == 0) : (((row - MP) & 31) == 0);
        if (st) { if (row < MP) { z1 = (f32x8)(0.f); z2 = (f32x8)(0.f); }
            else { const int s = (row - MP) >> 5; const float* pv = cstate + (size_t)s * 2 * D + c0; z2 = ld_f32x8(pv); z1 = ld_f32x8(pv + D); } }
        const f32x8 z0 = bf8_to_f32(zv[rr]), b0 = bf8_to_f32(bv[rr]);
        const f32x8 o = b0 * (w0 * z2 + w1 * z1 + w2 * z0); z2 = z1; z1 = z0;
        u32x4 w; w.x = cvt_pk_bf16(o[0], o[1]); w.y = cvt_pk_bf16(o[2], o[3]); w.z = cvt_pk_bf16(o[4], o[5]); w.w = cvt_pk_bf16(o[6], o[7]);
        *(u32x4*)(ZC + (size_t)row * D + c0) = w; }
}

constexpr int NPHASE = 10;
__global__ void __launch_bounds__(512, 2) mk_fwd(Args a) {
    extern __shared__ __attribute__((aligned(16))) unsigned char lds_raw[];
    LAS unsigned char* lds = (LAS unsigned char*)lds_raw;
    const int tid = threadIdx.x, lane = tid & 63, wave = __builtin_amdgcn_readfirstlane(tid >> 6);
    const int G = gridDim.x; const int bx = blockIdx.x; const int vcu = (G % 8 == 0) ? (bx % 8) * (G / 8) + bx / 8 : bx;
    unsigned char* ws = a.ws;
    volatile LAS unsigned* MISC = (volatile LAS unsigned*)(lds + LDSCTL_OFF);
    if (tid < 64) MISC[tid] = 0u;
    __syncthreads();
    XcdBarrier bar; bar.bar = (unsigned*)(ws + WS_CTL) + CW_BAR; bar.x = 0; bar.st = nullptr;
    const int lo = a.ph_lo, hi = a.ph_hi;
    if (hi - lo > 1) bar = xcd_barrier_post((unsigned*)(ws + WS_CTL) + CW_BAR, MISC + 8);
#define IN(k) (lo <= (k) && (k) < hi)
#define SEAM(k) do { if (IN(k) && IN((k) + 1)) xcd_barrier(bar); } while (0)
#ifndef DUP_PHASE
#define DUP_PHASE -1
#endif
#define REPS(k) ((DUP_PHASE) == (k) ? 2 : 1)
#define REP(k) for (int rep_ = 0; rep_ < REPS(k); ++rep_, (rep_ < REPS(k) ? xcd_barrier(bar) : (void)0))

    bf16_t* WGU = (bf16_t*)(ws + WS_WGU); bf16_t* WDt = (bf16_t*)(ws + WS_WD); bf16_t* WIN = (bf16_t*)(ws + WS_WIN); bf16_t* WCO = (bf16_t*)(ws + WS_WCO);
    bf16_t* WGLU = (bf16_t*)(ws + WS_WGLU); bf16_t* WOt = (bf16_t*)(ws + WS_WO); bf16_t* XA = (bf16_t*)(ws + WS_XA);
    bf16_t* R0 = (bf16_t*)(ws + WS_R); bf16_t* R1 = (bf16_t*)(ws + WS_R + SLOT); bf16_t* R2 = (bf16_t*)(ws + WS_R + 2 * SLOT); bf16_t* R3 = (bf16_t*)(ws + WS_R + 3 * SLOT); bf16_t* R4 = (bf16_t*)(ws + WS_R + 4 * SLOT);
    bf16_t* HB = R0;
    bf16_t* WGU1 = (bf16_t*)a.out; bf16_t* WD1 = WGU1 + (size_t)2 * FF * D;
    float* ss0 = (float*)(ws + WS_SS); float* ss1 = (float*)(ws + WS_SS + SS_BYTES); float* ss2 = (float*)(ws + WS_SS + 2 * SS_BYTES); float* ss3 = (float*)(ws + WS_SS + 3 * SS_BYTES);
    float* Y = a.out + O_Y;
    u32x2* PD2 = (u32x2*)((unsigned char*)a.out + 17 * MiB); u32x2* PDO = (u32x2*)a.out; u32x2* PD9 = (u32x2*)(ws + WS_XA);
    const int gw = vcu * 8 + wave, NGW = G * 8;

    if (IN(0)) REP(0) {
        const bool tables_first = (bx & 1) != 0;
        if (tables_first) for (int job = vcu; job < NG * 4; job += G) ssm_tables_job(a, lds, job >> 2, job & 3, tid);
        conv_range(a, lds, 0, 2 * IT_GU, gw, NGW, wave, lane);
        for (int m0 = gw; m0 < M; m0 += 4 * NGW) {
            f32x4 v[4][4]; int mr[4];
#pragma unroll
            for (int r = 0; r < 4; ++r) { const int m = m0 + r * NGW; mr[r] = m < M ? m : m0; const float* xr = (mr[r] < MP) ? a.in[0] + (size_t)mr[r] * D : a.in[1] + (size_t)(mr[r] - MP) * D;
#pragma unroll
                for (int j = 0; j < 4; ++j) v[r][j] = ((const f32x4*)xr)[lane + 64 * j]; }
#pragma unroll
            for (int r = 0; r < 4; ++r) { if (r > 0 && m0 + r * NGW >= M) break; float sq = 0.f;
#pragma unroll
                for (int j = 0; j < 4; ++j) sq += (v[r][j][0] * v[r][j][0] + v[r][j][1] * v[r][j][1]) + (v[r][j][2] * v[r][j][2] + v[r][j][3] * v[r][j][3]);
                sq = wave_sum(sq);
#pragma unroll
                for (int j = 0; j < 4; ++j) { u32x2 w; w.x = cvt_pk_bf16(v[r][j][0], v[r][j][1]); w.y = cvt_pk_bf16(v[r][j][2], v[r][j][3]); ((u32x2*)(XA + (size_t)mr[r] * D))[lane + 64 * j] = w; }
                if (lane == 0) *(f32x4*)(ss0 + (size_t)mr[r] * 4) = (f32x4){sq, 0.f, 0.f, 0.f}; }
        }
        __syncthreads();
        if (!tables_first) for (int job = vcu; job < NG * 4; job += G) ssm_tables_job(a, lds, job >> 2, job & 3, tid);
    }
    SEAM(0);
    if (IN(1)) REP(1) { pg8::Gemm g{XA, WGU1, M, 2 * FF, D, 2 * D, 32}; pg8::StaticOrder S; S.init(M, 2 * FF, D, G, bx, 1); pg8::EpiSwiGLU E{HB, ss0}; pg8::gemm_phase<false>(lds, g, S, E, nullptr, nullptr);
        if (S.r > 0 && bx >= S.r) { const int nw = (G - S.r) * 8; conv_range(a, lds, 2 * IT_GU, IT_FFN, (bx - S.r) * 8 + wave, nw, wave, lane); __syncthreads(); } }
    SEAM(1);
    if (IN(2)) REP(2) { pg8::Gemm g{HB, WD1, M, D, FF, 2 * FF, 32}; pg8::StaticOrder S; S.init(M, D, FF, G, bx, NSPLIT); pg8::EpiResid<true, false, true> E{nullptr, nullptr, XA, nullptr, XA, ss1, 0.5f};   pg8::gemm_phase<true>(lds, g, S, E, PD2, (unsigned*)(ws + WS_CTL) + CW_CNT + 0 * 2048);
        { const int nt_ = S.ns > 1 ? S.r * S.ns : 0; if (bx >= nt_ && nt_ < G) { const int nw = (G - nt_) * 8; conv_range(a, lds, ITB_WIN, ITB_CO, (bx - nt_) * 8 + wave, nw, wave, lane); __syncthreads(); } } }
    SEAM(2);
    if (IN(3)) { pg8::Gemm g{XA, WIN, M, NIN, D, 2 * D, 32}; pg8::ZFirstOrder S; unsigned* zdone = (unsigned*)(ws + WS_CTL) + CW_ZF; S.init(G, bx, zdone);
        pg8::EpiMixIn E{R0, R1, R2, (unsigned char*)R3, (unsigned char*)R4, ss1, a.out};
        pg8::gemm_phase<false>(lds, g, S, E, nullptr, nullptr);
        const int ntot = S.nA + S.nB, rlast = ntot - ((ntot - 1) / G) * G;
        const bool all_conv = (rlast == G);
        if (all_conv || bx >= rlast) {
            if (tid == 0) { unsigned sp = 0; while (__hip_atomic_load(zdone, __ATOMIC_RELAXED, __HIP_MEMORY_SCOPE_AGENT) < (unsigned)S.publishers()) { __builtin_amdgcn_s_sleep(2); if (++sp > (1u << 22)) break; }
                __builtin_amdgcn_fence(__ATOMIC_ACQUIRE, "agent"); asm volatile("s_waitcnt vmcnt(0)" ::: "memory"); }
            __syncthreads();
            const int cw = all_conv ? bx : bx - rlast, ncw = all_conv ? G : G - rlast, nruns = ncw * 4;
            const float* wc = a.in[11]; const float* cstate = a.in[2]; const bf16_t* Z = R0; bf16_t* BG = R1;
            const int run = cw * 4 + (tid >> 7), c0 = (tid & 127) * 8;
            const int r0 = (int)(((long)run * M) / nruns), r1 = (int)(((long)(run + 1) * M) / nruns);
            const f32x8 w0 = ld_f32x8(wc + c0), w1 = ld_f32x8(wc + D + c0), w2 = ld_f32x8(wc + 2 * D + c0); f32x8 z1 = (f32x8)(0.f), z2 = (f32x8)(0.f);
            { const bool st = (r0 < MP) ? ((r0 & 4095) == 0) : (((r0 - MP) & 31) == 0);
              if (!st) { const bool st1 = (r0 < MP) ? (((r0 - 1) & 4095) == 0) : (((r0 - 1 - MP) & 31) == 0);
                  z1 = bf8_to_f32(*(const u32x4*)(Z + (size_t)(r0 - 1) * D + c0));
                  if (!st1) z2 = bf8_to_f32(*(const u32x4*)(Z + (size_t)(r0 - 2) * D + c0));
                  else if (r0 - 1 >= MP) { const int sq = (r0 - 1 - MP) >> 5; z2 = ld_f32x8(cstate + ((size_t)sq * 2 + 1) * D + c0); } } }
            int r = r0;
            for (; r + 9 <= r1; r += 9) { int rr = r; asm volatile("" : "+v"(rr)); conv_rows<9>(cstate, Z, BG, BG, rr, c0, w0, w1, w2, z1, z2); }
            for (; r + 4 <= r1; r += 4) { int rr = r; asm volatile("" : "+v"(rr)); conv_rows<4>(cstate, Z, BG, BG, rr, c0, w0, w1, w2, z1, z2); }
            for (; r < r1; ++r) { int rr = r; asm volatile("" : "+v"(rr)); conv_rows<1>(cstate, Z, BG, BG, rr, c0, w0, w1, w2, z1, z2); }
            conv_range2(a, lds, ITB_CO, ITB_END, ITB_FFN2, ITB_FFN2 + X3_FFN2, cw * 8 + wave, ncw * 8, wave, lane); __syncthreads();
        }
    }
    SEAM(3);

    if (IN(5)) { pg8::Gemm g{R1, WCO, M, D, D, 2 * D, 32}; pg8::StaticOrder S; S.init(M, D, D, G, bx, NSPLIT); pg8::EpiConvOut E{(const unsigned char*)R3, R0}; pg8::gemm_phase<true>(lds, g, S, E, PDO, (unsigned*)(ws + WS_CTL) + CW_CNT + 1 * 2048);
        { const int ntail = S.ns > 1 ? S.r * S.ns : 0;
          for (int item = vcu; item < NB * NG; item += G) { const int g = item & 63, seq = item >> 6; SsmFrags F; ssm_item_begin(a, lds, g, seq * SEQ, F, tid);
              for (int t = 0; t < 4; ++t) ssm_tile<false>(a, lds, g, seq * SEQ + t * 1024, t, t == 0, t == 3, seq, F, t < 3, tid, R2 + ((size_t)g * M + seq * SEQ + t * 1024) * 16); }
          const int nfree = G - ntail;
          for (int j = (bx >= ntail ? bx - ntail : bx + nfree); j < NG; j += G) { SsmFrags F; ssm_item_begin(a, lds, j, MP, F, tid); ssm_tile<true>(a, lds, j, MP, 0, true, true, 0, F, false, tid, R2 + ((size_t)j * M + MP) * 16); }
          if (nfree > NG && bx >= ntail + NG) { __syncthreads(); conv_range(a, lds, ITB_FFN2 + X3_FFN2, ITB_FFN2 + X3_FFN2 + X5_FFN2, (bx - ntail - NG) * 8 + wave, (nfree - NG) * 8, wave, lane); __syncthreads(); }
        }
    }
    SEAM(5);
    if (IN(6)) REP(6) { pg8::Gemm g{R2, WGLU, M, 2 * D, D, 32, 32u * M}; pg8::StaticOrder S; S.init(M, 2 * D, D, G, bx, NSPLIT); pg8::EpiGlu E{R0, (const unsigned char*)R4, R0}; pg8::gemm_phase<true>(lds, g, S, E, PDO, (unsigned*)(ws + WS_CTL) + CW_CNT + 2 * 2048); }
    SEAM(6);
    if (IN(7)) { pg8::Gemm g{R0, WOt, M, D, D, 2 * D, 32}; pg8::StaticOrder S; S.init(M, D, D, G, bx, NSPLIT); pg8::EpiResid<true, false, true> E{nullptr, nullptr, XA, nullptr, R4, ss2, 1.0f}; pg8::gemm_phase<true>(lds, g, S, E, PDO, (unsigned*)(ws + WS_CTL) + CW_CNT + 3 * 2048);
        { const int nt_ = S.ns > 1 ? S.r * S.ns : 0; if (bx >= nt_ && nt_ < G) { const int x5 = (G - nt_ > NG) ? X5_FFN2 : 0; conv_range(a, lds, ITB_FFN2 + X3_FFN2 + x5, ITB_WIN, (bx - nt_) * 8 + wave, (G - nt_) * 8, wave, lane); __syncthreads(); } } }
    SEAM(7);
    if (IN(8)) REP(8) { pg8::Gemm g{R4, WGU, M, 2 * FF, D, 2 * D, 32}; pg8::StaticOrder S; S.init(M, 2 * FF, D, G, bx, 1); pg8::EpiSwiGLU E{HB, ss2}; pg8::gemm_phase<false>(lds, g, S, E, nullptr, nullptr); }
    SEAM(8);
    const bool fuse_final = (G == 256);
    if (IN(9)) { pg8::Gemm g{HB, WDt, M, D, FF, 2 * FF, 32}; pg8::StaticOrder S;
        if (fuse_final && S.init_tailpanels(M, D, FF, G, bx, MS / 256)) {
            unsigned* fc = (unsigned*)(ws + WS_CTL) + CW_FIN;
            pg8::EpiFinal E{R4, Y, ss3, fc, fc + 64 * (M / 256), a.in[27], 0.5f}; pg8::gemm_phase<true>(lds, g, S, E, PD9, (unsigned*)(ws + WS_CTL) + CW_CNT + 4 * 2048);
        }
    }
    SEAM(9);
#undef IN
#undef SEAM
}

extern "C" void kernel_launch(void* const* d_in, const int* in_sizes, int n_in, void* d_out, int out_size, void* d_ws, size_t ws_size, hipStream_t stream) {
    static int grid = 0;
    if (grid == 0) {
        if (n_in != 28 || ws_size < WS_END) { fprintf(stderr, "kernel_launch: unexpected inputs (n_in %d, ws %zu, need %zu)\n", n_in, ws_size, (size_t)WS_END); grid = -1; return; }
        int dev = 0, cus = 0;
        if (hipGetDevice(&dev) != hipSuccess || hipDeviceGetAttribute(&cus, hipDeviceAttributeMultiprocessorCount, dev) != hipSuccess) { grid = -1; return; }
        if (hipFuncSetAttribute((const void*)mk_fwd, hipFuncAttributeMaxDynamicSharedMemorySize, LDS_BYTES) != hipSuccess) { fprintf(stderr, "kernel_launch: hipFuncSetAttribute failed\n"); grid = -1; return; }
        int per_cu = 0;
        if (hipOccupancyMaxActiveBlocksPerMultiprocessor(&per_cu, (const void*)mk_fwd, 512, LDS_BYTES) != hipSuccess || per_cu < 1) fprintf(stderr, "kernel_launch: occupancy query says %d blocks/CU\n", per_cu);
        (void)hipGetLastError();
        grid = cus > 256 ? 256 : cus;
    }
    if (grid < 0) return;
    (void)hipMemsetAsync((char*)d_ws + WS_CTL, 0, CTL_ZERO_BYTES, stream);
    Args a{};
    for (int i = 0; i < 28; ++i) a.in[i] = (const float*)d_in[i];
    a.out = (float*)d_out; a.ws = (unsigned char*)d_ws;
#if MK_N_LAUNCHES == 1
    a.ph_lo = 0; a.ph_hi = NPHASE;
    hipLaunchKernelGGL(mk_fwd, dim3(grid), dim3(512), LDS_BYTES, stream, a);
#else
    for (int p = 0; p < NPHASE; ++p) { a.ph_lo = p; a.ph_hi = p + 1; hipLaunchKernelGGL(mk_fwd, dim3(grid), dim3(512), LDS_BYTES, stream, a); }
#endif
}
```

```cpp
#include <hip/hip_runtime.h>
#include <cstdio>
#include <cstdint>

#ifndef NSPLIT
#define NSPLIT 8
#endif
#ifndef PG8_SP2
#define PG8_SP2 1
#endif
#ifndef DUP_CONV
#define DUP_CONV 0
#endif
#ifndef MK_N_LAUNCHES
#define MK_N_LAUNCHES 1
#endif

constexpr int MP = 16384, MS = 1024, M = MP + MS;
constexpr int D = 1024, FF = 2816, NIN = 6144, NG = 64, NP = 64;
constexpr int SEQ = 4096, DSEQ = 32, NB = 4, NDB = 32;
constexpr float RMS_EPS = 1e-6f;
constexpr size_t O_Y = 0, O_CONVP = (size_t)M * D, O_SREP = O_CONVP + 8192, O_SIMP = O_SREP + 16384, O_CONVS = O_SIMP + 16384, O_SRES = O_CONVS + 65536, O_SIMS = O_SRES + 131072;

#define GAS __attribute__((address_space(1)))
#define LAS __attribute__((address_space(3)))
typedef unsigned short bf16_t;
typedef short bf16x8 __attribute__((ext_vector_type(8)));
typedef float f32x4 __attribute__((ext_vector_type(4)));
typedef float f32x2 __attribute__((ext_vector_type(2)));
typedef unsigned u32x4 __attribute__((ext_vector_type(4)));
typedef unsigned u32x2 __attribute__((ext_vector_type(2)));

__device__ __forceinline__ unsigned cvt_pk_bf16(float lo, float hi) { unsigned r; asm volatile("v_cvt_pk_bf16_f32 %0, %1, %2" : "=v"(r) : "v"(lo), "v"(hi)); return r; }
__device__ __forceinline__ float bf_lo(unsigned w) { return __uint_as_float(w << 16); }
__device__ __forceinline__ float bf_hi(unsigned w) { return __uint_as_float(w & 0xffff0000u); }
__device__ __forceinline__ float sigmoid_f(float v) { return __builtin_amdgcn_rcpf(1.0f + __builtin_amdgcn_exp2f(-1.4426950409f * v)); }
__device__ __forceinline__ float silu_f(float v) { return v * sigmoid_f(v); }
__device__ __forceinline__ float gelu_tanh_f(float v) { return v * sigmoid_f(1.5957691216f * (v + 0.044715f * v * v * v)); }

__device__ __forceinline__ void st16_wt(void* p, u32x4 v) { asm volatile("global_store_dwordx4 %0, %1, off sc1\n\ts_nop 1" :: "v"(p), "v"(v) : "memory"); }
#ifdef WT_STORES
__device__ __forceinline__ void st16(void* p, u32x4 v) { asm volatile("global_store_dwordx4 %0, %1, off sc1\n\ts_nop 1" :: "v"(p), "v"(v) : "memory"); }
__device__ __forceinline__ void st8(void* p, u32x2 v) { asm volatile("global_store_dwordx2 %0, %1, off sc1\n\ts_nop 1" :: "v"(p), "v"(v) : "memory"); }
#else
__device__ __forceinline__ void st16(void* p, u32x4 v) { *(u32x4*)p = v; }
__device__ __forceinline__ void st8(void* p, u32x2 v) { *(u32x2*)p = v; }
#endif

__device__ __forceinline__ u32x2 pack_unorm8(const float (&o)[8]) {
    u32x2 w = {0u, 0u};
#pragma unroll
    for (int j = 0; j < 4; ++j) { w.x = __builtin_amdgcn_cvt_pk_u8_f32(fmaf(o[j], 255.0f, 0.5f), j, w.x); w.y = __builtin_amdgcn_cvt_pk_u8_f32(fmaf(o[4 + j], 255.0f, 0.5f), j, w.y); }
    return w;
}
__device__ __forceinline__ float unorm8(unsigned w, int j) { return (float)((w >> (8 * j)) & 0xffu) * (1.0f / 255.0f); }

constexpr int RING_BYTES = 131072;
constexpr int SCR_OFF = RING_BYTES;
constexpr int LDS_BYTES = 163840;
constexpr int LDSCTL_OFF = LDS_BYTES - 512;

namespace pg8 {
constexpr int BM = 256, BK = 64, HALF = 128, HTB = HALF * BK * 2, NXCD = 8, WGM = 8;
__host__ __device__ __forceinline__ int lds_byte(int r, int c) { const int st = (r >> 4) * 2 + (c >> 5), rr = r & 15, cc = c & 31, ob = rr * 64 + cc * 2; return st * 1024 + (ob ^ (((ob >> 9) & 1) << 5)); }
__host__ __device__ __forceinline__ void stage_rc(int b, int& R, int& C) { const int st = b / 1024, sb = b % 1024, swz = sb ^ (((sb >> 9) & 1) << 5); R = (st >> 1) * 16 + swz / 64; C = (st & 1) * 32 + (swz % 64) / 2; }
__host__ __device__ __forceinline__ int perm32(int rho) { const int n = rho >> 4, i = rho & 15; return 8 * (i >> 2) + 4 * n + (i & 3); }

struct Unit { int pm, pn, kt0, nkt, part, tidx; };
struct Gemm { const bf16_t* A; const bf16_t* Bt; int M, N, K; unsigned a_rs, a_gs; };

struct StaticOrder {
    int nM, nN, nwg, G, c, nkt, ns, q, r, mp;
    __host__ __device__ __forceinline__ void init(int M_, int N_, int K_, int G_, int c_, int ns_) { nM = M_ / BM; nN = N_ / BM; nwg = nM * nN; G = G_; c = c_; nkt = K_ / BK; ns = ns_; q = nwg / G; r = nwg - q * G; mp = nM; if (ns != 8 || r == 0 || r * ns > G || nkt < 16) ns = 1; }
    __host__ __device__ __forceinline__ bool init_tailpanels(int M_, int N_, int K_, int G_, int c_, int tp) { nM = M_ / BM; nN = N_ / BM; nwg = nM * nN; G = G_; c = c_; nkt = K_ / BK; ns = 8; mp = nM - tp;
        q = (mp * nN) / G; r = tp * nN; return (mp * nN == q * G) && (r * ns <= G) && nkt >= 16; }
    __host__ __device__ __forceinline__ void tile(int L, Unit& u) const {
        const int nm = mp, nw = mp * nN;
        if (L >= nw) { const int j = L - nw; u.pm = mp + j / nN; u.pn = j % nN; return; }
        int wgid = L; { const int qq = nw / NXCD, rr = nw % NXCD, xcd = wgid % NXCD, off = wgid / NXCD; wgid = (xcd < rr ? xcd * (qq + 1) : rr * (qq + 1) + (xcd - rr) * qq) + off; }
        const int nig = WGM * nN, gid = wgid / nig, fm = gid * WGM, gsz = (nm - fm) < WGM ? (nm - fm) : WGM;
        u.pm = fm + ((wgid % nig) % gsz); u.pn = (wgid % nig) / gsz;
    }
    __device__ __forceinline__ void after_unit(int, int) const {}
    __host__ __device__ __forceinline__ bool next(int i, Unit& u) const {
        u.kt0 = 0; u.nkt = nkt; u.part = -1; u.tidx = 0;
        if (ns > 1) {
            const bool has_tail = c < r * ns;
            if (has_tail && i == 0) { u.tidx = c / ns; u.part = c % ns; tile(q * G + u.tidx, u);
                const int pairs = nkt / 2, p0 = u.part * pairs / ns, p1 = (u.part + 1) * pairs / ns; u.kt0 = 2 * p0; u.nkt = 2 * (p1 - p0); return true; }
            const int j = has_tail ? i - 1 : i; if (j >= q) return false;
            tile(j * G + c, u); return true; }
        const long L = (long)i * G + c; if (L >= nwg) return false;
        tile((int)L, u); return true;
    }
};

constexpr int ZF_N1 = 12;
struct ZFirstOrder {
    StaticOrder A, B; int nA, nB, G, c, nkt, last_a; unsigned* done;
    __device__ __forceinline__ void init(int G_, int c_, unsigned* done_) { G = G_; c = c_; done = done_; A.init(M, ZF_N1 * BM, D, G_, c_, 1); B.init(M, (NIN / BM - ZF_N1) * BM, D, G_, c_, 1); nA = A.nwg; nB = B.nwg; nkt = D / BK;
        last_a = (c < nA) ? (nA - 1 - c) / G : -1; }
    __device__ __forceinline__ bool next(int i, Unit& u) const {
        u.kt0 = 0; u.nkt = nkt; u.part = -1; u.tidx = 0; const int L = i * G + c;
        if (L < nA) { A.tile(L, u); return true; }
        if (L < nA + nB) { B.tile(L - nA, u); u.pn += ZF_N1; return true; }
        return false;
    }
    __device__ __forceinline__ void after_unit(int ui, int tid) const {
        if (ui != last_a) return;
        asm volatile("s_waitcnt vmcnt(0)" ::: "memory"); __syncthreads();
        if (tid == 0) { __builtin_amdgcn_fence(__ATOMIC_RELEASE, "agent"); asm volatile("s_waitcnt vmcnt(0)" ::: "memory"); __hip_atomic_fetch_add(done, 1u, __ATOMIC_RELAXED, __HIP_MEMORY_SCOPE_AGENT); }
    }
    __device__ __forceinline__ int publishers() const { return nA < G ? nA : G; }
    __device__ __forceinline__ bool has_last_round_unit() const { return ((nA + nB - 1) / G) * G + c < nA + nB; }
};

typedef f32x4 Acc[2][2][4][2];

__device__ __forceinline__ float rrms_of(const float* ss, int row) { const f32x4 p = *(const f32x4*)(ss + (size_t)row * 4); return rsqrtf(((p[0] + p[1]) + (p[2] + p[3])) * (1.0f / D) + RMS_EPS); }

typedef f32x4 Slice[2][2];
struct EpiSwiGLU {
    static constexpr bool PERM = true, IDEM = true, RSCALE = true, FINAL = false; static constexpr int BATCH = 1;
    bf16_t* H; const float* ss;
    struct In {};
    __device__ __forceinline__ In load(const Unit&, int, int, int, int, int, int) const { return In{}; }
    __device__ __forceinline__ void rows(const Slice& v, const In&, const Unit& u, int ai, int m, int wr, int wc, int fr, int fq, LAS float* scr) const {
        const int rt = ai * HALF + wr * 64 + m * 16 + fr, row = u.pm * BM + rt, col0 = u.pn * HALF + wc * 32 + 8 * fq; const float s = scr[rt], s2 = s * s, sl = -1.4426950409f * s;
        float o[8];
#pragma unroll
        for (int n = 0; n < 2; ++n)
#pragma unroll
            for (int j = 0; j < 4; ++j) { const float gg = v[0][n][j]; o[n * 4 + j] = (gg * v[1][n][j]) * (s2 * __builtin_amdgcn_rcpf(1.0f + __builtin_amdgcn_exp2f(gg * sl))); }
        u32x4 w; w.x = cvt_pk_bf16(o[0], o[1]); w.y = cvt_pk_bf16(o[2], o[3]); w.z = cvt_pk_bf16(o[4], o[5]); w.w = cvt_pk_bf16(o[6], o[7]);
        st16(H + (size_t)row * FF + col0, w);
    }
    __device__ __forceinline__ void finish(const Unit&, LAS unsigned char*, int, int) const {}
};

template <bool BASE_BF16, bool OUT_F32, bool OUT_BF16>
struct EpiResid {
    static constexpr bool PERM = true, IDEM = true, RSCALE = false, FINAL = false; static constexpr int BATCH = 4;
    const float* base_p; const float* base_s; const bf16_t* base_b; float* out; bf16_t* xb; float* ss; float alpha;
    struct In { f32x4 b[2][2]; u32x4 w[2]; };
    __device__ __forceinline__ In load(const Unit& u, int ai, int m, int wr, int wc, int fr, int fq) const {
        const int row = u.pm * BM + ai * HALF + wr * 64 + m * 16 + fr, col0 = u.pn * BM + wc * 32 + 8 * fq; const size_t off = (size_t)row * D + col0;
        const float* base = (u.pm < MP / BM) ? base_p : (base_s - (size_t)MP * D); In in;
#pragma unroll
        for (int bj = 0; bj < 2; ++bj) {
            if (BASE_BF16) in.w[bj] = *(const u32x4*)(base_b + off + bj * HALF);
            else { in.b[bj][0] = *(const f32x4*)(base + off + bj * HALF); in.b[bj][1] = *(const f32x4*)(base + off + bj * HALF + 4); } }
        return in;
    }
    __device__ __forceinline__ void rows(const Slice& v, const In& in, const Unit& u, int ai, int m, int wr, int wc, int fr, int fq, LAS float* scr) const {
        const int rt = ai * HALF + wr * 64 + m * 16 + fr, row = u.pm * BM + rt, col0 = u.pn * BM + wc * 32 + 8 * fq;
        const size_t off = (size_t)row * D + col0; float sq = 0.f;
#pragma unroll
        for (int bj = 0; bj < 2; ++bj) { f32x4 b0, b1;
            if (BASE_BF16) { const u32x4 w = in.w[bj]; b0 = (f32x4){bf_lo(w.x), bf_hi(w.x), bf_lo(w.y), bf_hi(w.y)}; b1 = (f32x4){bf_lo(w.z), bf_hi(w.z), bf_lo(w.w), bf_hi(w.w)}; } else { b0 = in.b[bj][0]; b1 = in.b[bj][1]; }
            const f32x4 x0 = b0 + alpha * v[bj][0], x1 = b1 + alpha * v[bj][1];
            if (OUT_F32) { *(f32x4*)(out + off + bj * HALF) = x0; *(f32x4*)(out + off + bj * HALF + 4) = x1; }
            sq += ((x0[0] * x0[0] + x0[1] * x0[1]) + (x0[2] * x0[2] + x0[3] * x0[3])) + ((x1[0] * x1[0] + x1[1] * x1[1]) + (x1[2] * x1[2] + x1[3] * x1[3]));
            if (OUT_BF16) { u32x4 w; w.x = cvt_pk_bf16(x0[0], x0[1]); w.y = cvt_pk_bf16(x0[2], x0[3]); w.z = cvt_pk_bf16(x1[0], x1[1]); w.w = cvt_pk_bf16(x1[2], x1[3]); st16(xb + off + bj * HALF, w); } }
        sq += __shfl_xor(sq, 16); sq += __shfl_xor(sq, 32);
        if (fq == 0) scr[rt * 4 + wc] = sq;
    }
    __device__ __forceinline__ void finish(const Unit& u, LAS unsigned char* lds, int tid, int sel) const {
        LAS float* scr = (LAS float*)(lds + SCR_OFF);
        asm volatile("s_waitcnt lgkmcnt(0)" ::: "memory"); __builtin_amdgcn_s_barrier(); asm volatile("" ::: "memory");
        if (tid < 256 && (sel < 0 || (((tid >> 7) * 4 + ((tid >> 4) & 3)) == sel))) { const f32x4 p = *(const LAS f32x4*)(scr + tid * 4); ss[(size_t)(u.pm * BM + tid) * 4 + u.pn] = (p[0] + p[1]) + (p[2] + p[3]); }
    }
};

struct EpiMixIn {
    static constexpr bool PERM = true, IDEM = true, RSCALE = true, FINAL = false; static constexpr int BATCH = 1;
    bf16_t *Z, *BG, *U; unsigned char *SG8C, *SG8S; const float* ss; float* dout;
    struct In {};
    __device__ __forceinline__ In load(const Unit&, int, int, int, int, int, int) const { return In{}; }
    __device__ __forceinline__ void rows(const Slice& v, const In&, const Unit& u, int ai, int m, int wr, int wc, int fr, int fq, LAS float* scr) const {
        const int rt = ai * HALF + wr * 64 + m * 16 + fr, row = u.pm * BM + rt; const int pn = u.pn; const float s = scr[rt];
        if (pn < 8) {
            const int col = pn * HALF + wc * 32 + 8 * fq; float o[8];
#pragma unroll
            for (int n = 0; n < 2; ++n)
#pragma unroll
                for (int j = 0; j < 4; ++j) o[n * 4 + j] = (s * v[0][n][j]) * (s * v[1][n][j]);
            u32x4 w; w.x = cvt_pk_bf16(o[0], o[1]); w.y = cvt_pk_bf16(o[2], o[3]); w.z = cvt_pk_bf16(o[4], o[5]); w.w = cvt_pk_bf16(o[6], o[7]);
            st16(Z + (size_t)row * D + col, w);
            int t, seq; float* cs;
            if (row < MP) { seq = row >> 12; t = (row & 4095) - (SEQ - 2); cs = dout + O_CONVP; } else { const int r2 = row - MP; seq = r2 >> 5; t = (r2 & 31) - (DSEQ - 2); cs = dout + O_CONVS; }
            if (t >= 0) { float* p = cs + ((size_t)seq * 2 + t) * D + col; *(f32x4*)p = (f32x4){o[0], o[1], o[2], o[3]}; *(f32x4*)(p + 4) = (f32x4){o[4], o[5], o[6], o[7]}; }
        } else {
#pragma unroll
            for (int bj = 0; bj < 2; ++bj) { const int cc = (pn & 3) * BM + bj * HALF + wc * 32 + 8 * fq; float o[8];
#pragma unroll
                for (int n = 0; n < 2; ++n)
#pragma unroll
                    for (int j = 0; j < 4; ++j) { const float x = s * v[bj][n][j]; o[n * 4 + j] = (pn >= 16) ? sigmoid_f(x) : x; }
                if (pn >= 16) { const u32x2 g8 = pack_unorm8(o); st8((pn < 20 ? SG8C : SG8S) + (size_t)row * D + cc, g8); }
                else { u32x4 w; w.x = cvt_pk_bf16(o[0], o[1]); w.y = cvt_pk_bf16(o[2], o[3]); w.z = cvt_pk_bf16(o[4], o[5]); w.w = cvt_pk_bf16(o[6], o[7]);
                    if (pn < 12) st16(BG + (size_t)row * D + cc, w);
                    else st16(U + ((size_t)(cc >> 4) * M + row) * 16 + (cc & 15), w); } }
        }
    }
    __device__ __forceinline__ void finish(const Unit&, LAS unsigned char*, int, int) const {}
};

struct EpiConvOut {
    static constexpr bool PERM = true, IDEM = true, RSCALE = false, FINAL = false; static constexpr int BATCH = 8;
    const unsigned char* G8; bf16_t* T;
    struct In { u32x2 g[2]; };
    __device__ __forceinline__ In load(const Unit& u, int ai, int m, int wr, int wc, int fr, int fq) const {
        const int row = u.pm * BM + ai * HALF + wr * 64 + m * 16 + fr, col0 = u.pn * BM + wc * 32 + 8 * fq; In in;
#pragma unroll
        for (int bj = 0; bj < 2; ++bj) in.g[bj] = *(const u32x2*)(G8 + (size_t)row * D + col0 + bj * HALF);
        return in;
    }
    __device__ __forceinline__ void rows(const Slice& v, const In& in, const Unit& u, int ai, int m, int wr, int wc, int fr, int fq, LAS float*) const {
        const int row = u.pm * BM + ai * HALF + wr * 64 + m * 16 + fr, col0 = u.pn * BM + wc * 32 + 8 * fq;
#pragma unroll
        for (int bj = 0; bj < 2; ++bj) { const u32x2 g = in.g[bj]; u32x4 w;
            w.x = cvt_pk_bf16(unorm8(g.x, 0) * v[bj][0][0], unorm8(g.x, 1) * v[bj][0][1]); w.y = cvt_pk_bf16(unorm8(g.x, 2) * v[bj][0][2], unorm8(g.x, 3) * v[bj][0][3]);
            w.z = cvt_pk_bf16(unorm8(g.y, 0) * v[bj][1][0], unorm8(g.y, 1) * v[bj][1][1]); w.w = cvt_pk_bf16(unorm8(g.y, 2) * v[bj][1][2], unorm8(g.y, 3) * v[bj][1][3]);
            st16(T + (size_t)row * D + col0 + bj * HALF, w); }
    }
    __device__ __forceinline__ void finish(const Unit&, LAS unsigned char*, int, int) const {}
};

struct EpiGlu {
    static constexpr bool PERM = true, IDEM = true, RSCALE = false, FINAL = false; static constexpr int BATCH = 8;
    const bf16_t* T0; const unsigned char* SG8; bf16_t* MG;
    struct In { u32x4 t; u32x2 g; };
    __device__ __forceinline__ In load(const Unit& u, int ai, int m, int wr, int wc, int fr, int fq) const {
        const int row = u.pm * BM + ai * HALF + wr * 64 + m * 16 + fr, col0 = u.pn * HALF + wc * 32 + 8 * fq; const size_t off = (size_t)row * D + col0;
        In in; in.t = *(const u32x4*)(T0 + off); in.g = *(const u32x2*)(SG8 + off); return in;
    }
    __device__ __forceinline__ void rows(const Slice& v, const In& in, const Unit& u, int ai, int m, int wr, int wc, int fr, int fq, LAS float*) const {
        const int row = u.pm * BM + ai * HALF + wr * 64 + m * 16 + fr, col0 = u.pn * HALF + wc * 32 + 8 * fq; const size_t off = (size_t)row * D + col0;
        const u32x4 t = in.t; const u32x2 g = in.g; float o[8];
        const float tv[8] = {bf_lo(t.x), bf_hi(t.x), bf_lo(t.y), bf_hi(t.y), bf_lo(t.z), bf_hi(t.z), bf_lo(t.w), bf_hi(t.w)};
        const float gv[8] = {unorm8(g.x, 0), unorm8(g.x, 1), unorm8(g.x, 2), unorm8(g.x, 3), unorm8(g.y, 0), unorm8(g.y, 1), unorm8(g.y, 2), unorm8(g.y, 3)};
#pragma unroll
        for (int n = 0; n < 2; ++n)
#pragma unroll
            for (int j = 0; j < 4; ++j) o[n * 4 + j] = tv[n * 4 + j] + gv[n * 4 + j] * v[0][n][j] * sigmoid_f(v[1][n][j]);
        u32x4 w; w.x = cvt_pk_bf16(o[0], o[1]); w.y = cvt_pk_bf16(o[2], o[3]); w.z = cvt_pk_bf16(o[4], o[5]); w.w = cvt_pk_bf16(o[6], o[7]);
        st16(MG + off, w);
    }
    __device__ __forceinline__ void finish(const Unit&, LAS unsigned char*, int, int) const {}
};

struct EpiFinal {
    static constexpr bool PERM = true, IDEM = false, RSCALE = false, FINAL = true;
    const bf16_t* base_b; float* Y; float* xs; unsigned* cnt; unsigned* cnt2; const float* g; float alpha;
    struct In { u32x4 w[2]; };
    struct Gv { f32x4 g[2][2]; };
    __device__ __forceinline__ In load(const Unit& u, int ai, int m, int wr, int wc, int fr, int fq) const {
        const int row = u.pm * BM + ai * HALF + wr * 64 + m * 16 + fr, col0 = u.pn * BM + wc * 32 + 8 * fq; const size_t off = (size_t)row * D + col0; In in;
#pragma unroll
        for (int bj = 0; bj < 2; ++bj) in.w[bj] = *(const u32x4*)(base_b + off + bj * HALF);
        return in;
    }
    __device__ __forceinline__ Gv load_g(const Unit& u, int wc, int fq) const { const int col0 = u.pn * BM + wc * 32 + 8 * fq; Gv r;
#pragma unroll
        for (int bj = 0; bj < 2; ++bj)
#pragma unroll
            for (int n = 0; n < 2; ++n) r.g[bj][n] = *(const f32x4*)(g + col0 + bj * HALF + n * 4);
        return r; }
    __device__ __forceinline__ void pass1(Slice& v, const In& in, const Unit& u, int ai, int m, int wr, int wc, int fr, int fq, LAS float* scr) const {
        const int rt = ai * HALF + wr * 64 + m * 16 + fr; float sq = 0.f;
#pragma unroll
        for (int bj = 0; bj < 2; ++bj) { const u32x4 w = in.w[bj];
#pragma unroll
            for (int n = 0; n < 2; ++n) { const unsigned w0 = n ? w.z : w.x, w1 = n ? w.w : w.y; const f32x4 b = {bf_lo(w0), bf_hi(w0), bf_lo(w1), bf_hi(w1)};
                const f32x4 x = b + alpha * v[bj][n]; v[bj][n] = x; sq += (x[0] * x[0] + x[1] * x[1]) + (x[2] * x[2] + x[3] * x[3]); } }
        sq += __shfl_xor(sq, 16); sq += __shfl_xor(sq, 32);
        if (fq == 0) scr[rt * 4 + wc] = sq;
    }
    __device__ __forceinline__ void exchange(const Unit& u, int sel, LAS unsigned char* lds, int tid) const {
        LAS float* scr = (LAS float*)(lds + SCR_OFF); const int wid = __builtin_amdgcn_readfirstlane(tid >> 6), lane = tid & 63;
        const bool mine = tid < 256 && (sel < 0 || (((tid >> 7) * 4 + ((tid >> 4) & 3)) == sel));
        unsigned* c = sel < 0 ? cnt + 64 * u.pm : cnt2 + 64 * ((u.pm - MP / BM) * 8 + sel);
        asm volatile("s_waitcnt lgkmcnt(0)" ::: "memory"); __builtin_amdgcn_s_barrier(); asm volatile("" ::: "memory");
        if (mine) { const f32x4 p = *(const LAS f32x4*)(scr + tid * 4); __hip_atomic_store((unsigned*)(xs + (size_t)(u.pm * BM + tid) * 4 + u.pn), __float_as_uint((p[0] + p[1]) + (p[2] + p[3])), __ATOMIC_RELAXED, __HIP_MEMORY_SCOPE_AGENT); }
        asm volatile("s_waitcnt vmcnt(0)" ::: "memory");
        if (lane == 0) __hip_atomic_fetch_add(c, 1u, __ATOMIC_RELAXED, __HIP_MEMORY_SCOPE_AGENT);
        if (wid == 0) { unsigned sp = 0; while ((unsigned)__builtin_amdgcn_readfirstlane(__hip_atomic_load(c, __ATOMIC_RELAXED, __HIP_MEMORY_SCOPE_AGENT)) < 32u) { __builtin_amdgcn_s_sleep(2); if (++sp > (1u << 22)) break; }
            __builtin_amdgcn_fence(__ATOMIC_ACQUIRE, "agent"); }
        asm volatile("s_waitcnt vmcnt(0) lgkmcnt(0)" ::: "memory"); __builtin_amdgcn_s_barrier(); asm volatile("" ::: "memory");
        if (mine) { const unsigned* sl = (const unsigned*)(xs + (size_t)(u.pm * BM + tid) * 4); float t = 0.f;
#pragma unroll
            for (int k = 0; k < 4; ++k) t += __uint_as_float(__hip_atomic_load(sl + k, __ATOMIC_RELAXED, __HIP_MEMORY_SCOPE_AGENT));
            scr[1024 + tid] = rsqrtf(t * (1.0f / D) + RMS_EPS); }
        asm volatile("s_waitcnt lgkmcnt(0)" ::: "memory"); __builtin_amdgcn_s_barrier(); asm volatile("" ::: "memory");
    }
    __device__ __forceinline__ void pass2(const Slice& v, const Gv& gv, const Unit& u, int ai, int m, int wr, int wc, int fr, int fq, const LAS float* scr) const {
        const int rt = ai * HALF + wr * 64 + m * 16 + fr, row = u.pm * BM + rt, col0 = u.pn * BM + wc * 32 + 8 * fq; const size_t off = (size_t)row * D + col0; const float s = scr[1024 + rt];
#pragma unroll
        for (int bj = 0; bj < 2; ++bj)
#pragma unroll
            for (int n = 0; n < 2; ++n) *(f32x4*)(Y + off + bj * HALF + n * 4) = v[bj][n] * s * gv.g[bj][n];
    }
};

template <class Epi>
__device__ __forceinline__ void run_epilogue(const Epi& E, const Acc& acc, const Unit& u, int wr, int wc, int fr, int fq, LAS unsigned char* lds, int tid, int par, bool has_next, int next_pm) {
    LAS float* scr = (LAS float*)(lds + SCR_OFF);
    LAS float* tab = scr + 1024 + par * 256;
    f32x4 nx = {1.f, 1.f, 1.f, 1.f};
    if constexpr (Epi::RSCALE) { if (has_next) nx = *(const f32x4*)(E.ss + (size_t)(next_pm * BM + (tid & 255)) * 4); }
    constexpr int NB = Epi::BATCH;
#pragma unroll
    for (int k0 = 0; k0 < 8; k0 += NB) { typename Epi::In in[NB];
#pragma unroll
        for (int k = 0; k < NB; ++k) in[k] = E.load(u, (k0 + k) >> 2, (k0 + k) & 3, wr, wc, fr, fq);
#pragma unroll
        for (int k = 0; k < NB; ++k) { const int ai = (k0 + k) >> 2, m = (k0 + k) & 3;
            const Slice v = {{acc[ai][0][m][0], acc[ai][0][m][1]}, {acc[ai][1][m][0], acc[ai][1][m][1]}}; E.rows(v, in[k], u, ai, m, wr, wc, fr, fq, Epi::RSCALE ? tab : scr); } }
    if (Epi::RSCALE && has_next) scr[1024 + (par ^ 1) * 256 + (tid & 255)] = rsqrtf(((nx[0] + nx[1]) + (nx[2] + nx[3])) * (1.0f / D) + RMS_EPS);
    E.finish(u, lds, tid, -1);
}
__device__ __forceinline__ void store_partial(u32x2* P, int ns, const Acc& acc, const Unit& u, int tid) {
    u32x2* p = P + ((size_t)(u.tidx * ns + u.part) * 32) * 512 + tid;
#pragma unroll
    for (int ai = 0; ai < 2; ++ai)
#pragma unroll
        for (int bj = 0; bj < 2; ++bj)
#pragma unroll
            for (int m = 0; m < 4; ++m)
#pragma unroll
                for (int n = 0; n < 2; ++n) { const f32x4 v = acc[ai][bj][m][n]; u32x2 w; w.x = cvt_pk_bf16(v[0], v[1]); w.y = cvt_pk_bf16(v[2], v[3]);
                    asm volatile("global_store_dwordx2 %0, %1, off sc1\n\ts_nop 1" :: "v"(&p[(size_t)((((ai * 2 + bj) * 4 + m) * 2 + n)) * 512]), "v"(w) : "memory"); }
}
template <bool SPLIT, class Epi, class Ord>
__device__ __forceinline__ void gemm_phase(LAS unsigned char* lds, const Gemm g, const Ord& S, const Epi& E, u32x2* P, unsigned* cnt) {
    const int tid = threadIdx.x, wid = __builtin_amdgcn_readfirstlane(tid >> 6), lane = tid & 63, wr = wid >> 2, wc = wid & 3, fr = lane & 15, fq = lane >> 4;
    const int K = g.K;
    unsigned voffA[2], voffB[2];
#pragma unroll
    for (int i = 0; i < 2; ++i) { int R, C; stage_rc(tid * 16 + i * 8192, R, C); const int Rb = Epi::PERM ? ((R & ~31) + perm32(R & 31)) : R;
        voffA[i] = (unsigned)R * g.a_rs + (unsigned)(C >> 4) * g.a_gs + (unsigned)(C & 15) * 2u; voffB[i] = (unsigned)(Rb * K + C) * 2u; }
    const size_t kstepA = (size_t)4 * g.a_gs, hstepA = (size_t)HALF * g.a_rs, tstepA = 2 * hstepA;
    const size_t kstepB = (size_t)(BK * 2), hstepB = (size_t)HALF * K * 2, tstepB = 2 * hstepB;
    const unsigned ldsw = (unsigned)wid * 1024u;
    const int aoff = lds_byte(wr * 64 + fr, fq * 8), boff = lds_byte(wc * 32 + fr, fq * 8);
#define PG8_SA(b, h) (((b) * 2 + (h)) * HTB)
#define PG8_SB(b, h) ((4 + (b) * 2 + (h)) * HTB)
#define PG8_STAGE(bufoff, gbase, voff) do { _Pragma("unroll") for (int _i = 0; _i < 2; ++_i) \
        __builtin_amdgcn_global_load_lds((const unsigned*)((const char*)(gbase) + (voff)[_i]), (LAS unsigned*)(lds + (bufoff) + ldsw + _i * 8192), 16, 0, 0); } while (0)
#define PG8_LDA(dst, b, h) do { _Pragma("unroll") for (int m = 0; m < 4; ++m) _Pragma("unroll") for (int k = 0; k < 2; ++k) dst[m][k] = *(const LAS bf16x8*)(lds + PG8_SA(b, h) + aoff + m * 2048 + k * 1024); } while (0)
#define PG8_LDB(dst, b, h) do { _Pragma("unroll") for (int n = 0; n < 2; ++n) _Pragma("unroll") for (int k = 0; k < 2; ++k) dst[n][k] = *(const LAS bf16x8*)(lds + PG8_SB(b, h) + boff + n * 2048 + k * 1024); } while (0)
#define PG8_MMA(ai, bj, At, Bt) do { __builtin_amdgcn_s_setprio(1); _Pragma("unroll") for (int m = 0; m < 4; ++m) _Pragma("unroll") for (int n = 0; n < 2; ++n) _Pragma("unroll") for (int k = 0; k < 2; ++k) \
        acc[ai][bj][m][n] = __builtin_amdgcn_mfma_f32_16x16x32_bf16(Bt[n][k], At[m][k], acc[ai][bj][m][n], 0, 0, 0); __builtin_amdgcn_s_setprio(0); } while (0)
#define PG8_WAIT_V(n) asm volatile("s_waitcnt vmcnt(" #n ")" ::: "memory")
#define PG8_WAIT_L(n) asm volatile("s_waitcnt lgkmcnt(" #n ")" ::: "memory")
#define PG8_BAR __builtin_amdgcn_s_barrier()
#define PG8_SCHED __builtin_amdgcn_sched_barrier(0)
    Unit cur, nxt; int ui = 0;
    if (!S.next(0, cur)) return;
    Acc acc;
#pragma unroll
    for (int a = 0; a < 2; ++a)
#pragma unroll
        for (int b = 0; b < 2; ++b)
#pragma unroll
            for (int m = 0; m < 4; ++m)
#pragma unroll
                for (int n = 0; n < 2; ++n) acc[a][b][m][n] = (f32x4){0.f, 0.f, 0.f, 0.f};
    bf16x8 At[4][2], B0[2][2], B1[2][2];
    if constexpr (Epi::RSCALE) { if (tid < 256) ((LAS float*)(lds + SCR_OFF))[1024 + tid] = rrms_of(E.ss, cur.pm * BM + tid); }
    const char* cA = (const char*)g.A + (size_t)cur.pm * tstepA + (size_t)cur.kt0 * kstepA; const char* cB = (const char*)g.Bt + (size_t)cur.pn * tstepB + (size_t)cur.kt0 * kstepB;
#if PG8_SP2
    PG8_STAGE(PG8_SB(0, 0), cB, voffB); PG8_STAGE(PG8_SB(0, 1), cB + hstepB, voffB); PG8_STAGE(PG8_SA(0, 0), cA, voffA); PG8_STAGE(PG8_SA(0, 1), cA + hstepA, voffA);
    if (wr == 1) PG8_BAR;
    PG8_WAIT_V(2); PG8_BAR;
    PG8_STAGE(PG8_SB(1, 0), cB + kstepB, voffB); PG8_STAGE(PG8_SA(1, 0), cA + kstepA, voffA); PG8_STAGE(PG8_SB(1, 1), cB + hstepB + kstepB, voffB);
    PG8_WAIT_V(6); PG8_BAR;
#else
    PG8_STAGE(PG8_SB(0, 0), cB, voffB); PG8_STAGE(PG8_SA(0, 0), cA, voffA); PG8_STAGE(PG8_SB(0, 1), cB + hstepB, voffB); PG8_STAGE(PG8_SA(0, 1), cA + hstepA, voffA);
    if (wr == 1) PG8_BAR;
    PG8_WAIT_V(4); PG8_BAR;
    PG8_STAGE(PG8_SB(1, 0), cB + kstepB, voffB); PG8_STAGE(PG8_SA(1, 0), cA + kstepA, voffA); PG8_STAGE(PG8_SB(1, 1), cB + hstepB + kstepB, voffB);
    PG8_WAIT_V(6); PG8_BAR;
#endif
    for (;;) {
#ifdef KDUP
        const bool has_next = S.next((ui + 1) >> 1, nxt); const bool do_epi = (ui & 1) != 0;
#else
        const bool has_next = S.next(ui + 1, nxt); const bool do_epi = true;
#endif
        const char* nA = has_next ? (const char*)g.A + (size_t)nxt.pm * tstepA + (size_t)nxt.kt0 * kstepA : cA; const char* nB = has_next ? (const char*)g.Bt + (size_t)nxt.pn * tstepB + (size_t)nxt.kt0 * kstepB : cB;
        const int nt = cur.nkt;
        for (int t = 0; t < nt; t += 2) {
            const bool last = (t == nt - 2);
            const char* a1 = cA + (size_t)(t + 1) * kstepA;
            const char* a2 = last ? nA : cA + (size_t)(t + 2) * kstepA; const char* b2 = last ? nB : cB + (size_t)(t + 2) * kstepB;
            const char* a3 = a2 + kstepA; const char* b3 = b2 + kstepB;
#if PG8_SP2
            PG8_LDB(B0, 0, 0); PG8_LDB(B1, 0, 1); PG8_SCHED; PG8_LDA(At, 0, 0); PG8_STAGE(PG8_SA(1, 1), a1 + hstepA, voffA);
            PG8_WAIT_V(8); PG8_WAIT_L(0); PG8_BAR; PG8_MMA(0, 0, At, B0); PG8_MMA(0, 1, At, B1); PG8_BAR; PG8_SCHED;
            PG8_LDA(At, 0, 1); PG8_STAGE(PG8_SB(0, 0), b2, voffB); PG8_STAGE(PG8_SB(0, 1), b2 + hstepB, voffB); PG8_STAGE(PG8_SA(0, 0), a2, voffA);
            PG8_WAIT_V(8); PG8_WAIT_L(0); PG8_BAR; PG8_MMA(1, 0, At, B0); PG8_MMA(1, 1, At, B1); PG8_BAR; PG8_SCHED;
            PG8_LDB(B0, 1, 0); PG8_LDB(B1, 1, 1); PG8_SCHED; PG8_LDA(At, 1, 0); PG8_STAGE(PG8_SA(0, 1), a2 + hstepA, voffA);
            PG8_WAIT_V(8); PG8_WAIT_L(0); PG8_BAR; PG8_MMA(0, 0, At, B0); PG8_MMA(0, 1, At, B1); PG8_BAR; PG8_SCHED;
            PG8_LDA(At, 1, 1); PG8_STAGE(PG8_SB(1, 0), b3, voffB); PG8_STAGE(PG8_SB(1, 1), b3 + hstepB, voffB); PG8_STAGE(PG8_SA(1, 0), a3, voffA);
            PG8_WAIT_V(8); PG8_WAIT_L(0); PG8_BAR; PG8_MMA(1, 0, At, B0); PG8_MMA(1, 1, At, B1); PG8_BAR; PG8_SCHED;
#else
            PG8_LDB(B0, 0, 0); PG8_SCHED; PG8_LDA(At, 0, 0); PG8_STAGE(PG8_SA(1, 1), a1 + hstepA, voffA);
            PG8_WAIT_L(8); PG8_BAR; PG8_WAIT_L(0); PG8_MMA(0, 0, At, B0); PG8_BAR; PG8_SCHED;
            PG8_LDB(B1, 0, 1); PG8_STAGE(PG8_SB(0, 0), b2, voffB);
            PG8_BAR; PG8_WAIT_L(0); PG8_MMA(0, 1, At, B1); PG8_BAR;
            PG8_LDA(At, 0, 1); PG8_STAGE(PG8_SA(0, 0), a2, voffA);
            PG8_BAR; PG8_WAIT_L(0); PG8_MMA(1, 0, At, B0); PG8_BAR; PG8_SCHED;
            PG8_STAGE(PG8_SB(0, 1), b2 + hstepB, voffB);
            PG8_WAIT_V(6); PG8_BAR; PG8_MMA(1, 1, At, B1); PG8_BAR;
            PG8_LDB(B0, 1, 0); PG8_SCHED; PG8_LDA(At, 1, 0); PG8_STAGE(PG8_SA(0, 1), a2 + hstepA, voffA);
            PG8_WAIT_L(8); PG8_BAR; PG8_WAIT_L(0); PG8_MMA(0, 0, At, B0); PG8_BAR; PG8_SCHED;
            PG8_LDB(B1, 1, 1); PG8_STAGE(PG8_SB(1, 0), b3, voffB);
            PG8_BAR; PG8_WAIT_L(0); PG8_MMA(0, 1, At, B1); PG8_BAR;
            PG8_LDA(At, 1, 1); PG8_STAGE(PG8_SA(1, 0), a3, voffA);
            PG8_BAR; PG8_WAIT_L(0); PG8_MMA(1, 0, At, B0); PG8_BAR; PG8_SCHED;
            PG8_STAGE(PG8_SB(1, 1), b3 + hstepB, voffB);
            PG8_WAIT_V(6); PG8_BAR; PG8_MMA(1, 1, At, B1); PG8_BAR;
#endif
        }
        if (wr == 0) PG8_BAR;
#ifdef KDUP
        if (do_epi) { _Pragma("unroll") for (int a_ = 0; a_ < 2; ++a_) _Pragma("unroll") for (int b_ = 0; b_ < 2; ++b_) _Pragma("unroll") for (int m_ = 0; m_ < 4; ++m_) _Pragma("unroll") for (int n_ = 0; n_ < 2; ++n_) acc[a_][b_][m_][n_] *= 0.5f; }
#endif
        if (!do_epi) {}
#ifdef EDUP
        else if (!SPLIT || cur.part < 0) { static_assert(!Epi::FINAL, "EDUP probe predates the fused final epilogue"); run_epilogue(E, acc, cur, wr, wc, fr, fq, lds, tid, ui & 1, false, 0); if (Epi::IDEM) { asm volatile("" ::: "memory"); run_epilogue(E, acc, cur, wr, wc, fr, fq, lds, tid, ui & 1, has_next, nxt.pm); } }
#else
        else if (!SPLIT || cur.part < 0) {
            if constexpr (Epi::FINAL) { LAS float* scr = (LAS float*)(lds + SCR_OFF);
                { typename Epi::In in[8];
#pragma unroll
                  for (int k = 0; k < 8; ++k) in[k] = E.load(cur, k >> 2, k & 3, wr, wc, fr, fq);
#pragma unroll
                  for (int k = 0; k < 8; ++k) { const int ai = k >> 2, m = k & 3; Slice v = {{acc[ai][0][m][0], acc[ai][0][m][1]}, {acc[ai][1][m][0], acc[ai][1][m][1]}}; E.pass1(v, in[k], cur, ai, m, wr, wc, fr, fq, scr);
                      acc[ai][0][m][0] = v[0][0]; acc[ai][0][m][1] = v[0][1]; acc[ai][1][m][0] = v[1][0]; acc[ai][1][m][1] = v[1][1]; } }
                const typename Epi::Gv gv = E.load_g(cur, wc, fq);
                E.exchange(cur, -1, lds, tid);
#pragma unroll
                for (int ai = 0; ai < 2; ++ai)
#pragma unroll
                    for (int m = 0; m < 4; ++m) { const Slice v = {{acc[ai][0][m][0], acc[ai][0][m][1]}, {acc[ai][1][m][0], acc[ai][1][m][1]}}; E.pass2(v, gv, cur, ai, m, wr, wc, fr, fq, scr); }
            } else run_epilogue(E, acc, cur, wr, wc, fr, fq, lds, tid, ui & 1, has_next, nxt.pm);
            S.after_unit(ui, tid);
        }
#endif
        else {
            store_partial(P, 8, acc, cur, tid);
            asm volatile("s_waitcnt vmcnt(0)" ::: "memory"); __syncthreads();
            if (tid == 0) { unsigned* c = cnt + 64 * cur.tidx;
                __hip_atomic_fetch_add(c, 1u, __ATOMIC_RELAXED, __HIP_MEMORY_SCOPE_AGENT);
                unsigned sp = 0; while (__hip_atomic_load(c, __ATOMIC_RELAXED, __HIP_MEMORY_SCOPE_AGENT) < 8u) { __builtin_amdgcn_s_sleep(1); if (++sp > (1u << 22)) break; } }
            __syncthreads();
            const int sel = cur.part, sai = sel >> 2, sm = sel & 3; LAS float* scr = (LAS float*)(lds + SCR_OFF);
            Slice v = {{{0.f, 0.f, 0.f, 0.f}, {0.f, 0.f, 0.f, 0.f}}, {{0.f, 0.f, 0.f, 0.f}, {0.f, 0.f, 0.f, 0.f}}};
            { u32x2 t[8][2][2];
#pragma unroll
              for (int pp = 0; pp < 8; ++pp) { const u32x2* p = P + ((size_t)(cur.tidx * 8 + pp) * 32) * 512 + tid;
#pragma unroll
                  for (int bj = 0; bj < 2; ++bj)
#pragma unroll
                      for (int n = 0; n < 2; ++n) { const unsigned long long q8 = __hip_atomic_load((const unsigned long long*)&p[(size_t)((((sai * 2 + bj) * 4 + sm) * 2 + n)) * 512], __ATOMIC_RELAXED, __HIP_MEMORY_SCOPE_AGENT);
                          t[pp][bj][n] = (u32x2){(unsigned)q8, (unsigned)(q8 >> 32)}; } }
#pragma unroll
              for (int pp = 0; pp < 8; ++pp)
#pragma unroll
                  for (int bj = 0; bj < 2; ++bj)
#pragma unroll
                      for (int n = 0; n < 2; ++n) { const u32x2 w = t[pp][bj][n]; v[bj][n] += (f32x4){bf_lo(w.x), bf_hi(w.x), bf_lo(w.y), bf_hi(w.y)}; } }
            Unit fu = cur; fu.part = -1;
            if constexpr (Epi::FINAL) { const typename Epi::In fin = E.load(fu, sai, sm, wr, wc, fr, fq); const typename Epi::Gv gv = E.load_g(fu, wc, fq); E.pass1(v, fin, fu, sai, sm, wr, wc, fr, fq, scr); E.exchange(fu, sel, lds, tid); E.pass2(v, gv, fu, sai, sm, wr, wc, fr, fq, scr); }
            else { const typename Epi::In fin = E.load(fu, sai, sm, wr, wc, fr, fq); E.rows(v, fin, fu, sai, sm, wr, wc, fr, fq, scr); E.finish(fu, lds, tid, sel); }
        }
        if (!has_next) break;
        if (do_epi) {
#pragma unroll
        for (int a = 0; a < 2; ++a)
#pragma unroll
            for (int b = 0; b < 2; ++b)
#pragma unroll
                for (int m = 0; m < 4; ++m)
#pragma unroll
                    for (int n = 0; n < 2; ++n) acc[a][b][m][n] = (f32x4){0.f, 0.f, 0.f, 0.f};
        }
        cur = nxt; cA = nA; cB = nB; ++ui;
        if (wr == 1) PG8_BAR;
    }
    PG8_WAIT_V(0);
    PG8_BAR;
#undef PG8_SA
#undef PG8_SB
#undef PG8_STAGE
#undef PG8_LDA
#undef PG8_LDB
#undef PG8_MMA
#undef PG8_WAIT_V
#undef PG8_WAIT_L
#undef PG8_BAR
#undef PG8_SCHED
}
}

constexpr size_t MiB = 1u << 20;
constexpr size_t WS_CTL = 0, CTL_ZERO_BYTES = 128 * 1024;
constexpr size_t WS_SS = 1 * MiB;
constexpr size_t SS_BYTES = (size_t)M * 4 * 4;
constexpr size_t WS_W1T = 3 * MiB, WS_W3T = 7 * MiB, WS_TOEP = 11 * MiB, WS_LAM = 12 * MiB;
constexpr size_t WS_WGU = 13 * MiB;
constexpr size_t WS_WD = 24 * MiB;
constexpr size_t WS_WIN = WS_WD + (size_t)D * FF * 2;
constexpr size_t WS_WCO = WS_WIN + (size_t)NIN * D * 2;
constexpr size_t WS_WGLU = WS_WCO + (size_t)D * D * 2;
constexpr size_t WS_WO = WS_WGLU + (size_t)2 * D * D * 2;
constexpr size_t WS_XA = 50 * MiB;
constexpr size_t SLOT = (size_t)M * D * 2;
constexpr size_t WS_R = 84 * MiB;
constexpr size_t WS_END = WS_R + 5 * SLOT;
static_assert(WS_WO + (size_t)D * D * 2 <= WS_XA && WS_XA + SLOT <= WS_R && WS_END <= 256 * MiB && (size_t)M * FF * 2 <= 4 * SLOT, "d_ws map");
constexpr int CW_BAR = 1024;
constexpr int CW_FIN = 16384;
constexpr int CW_ZF = 4992;
constexpr int CW_CNT = 5120;

#define XB_TMO      128
#define XB_XCNT(j)  (256  + 64 * (j))
#define XB_XSUB(j)  (1280 + 64 * (j))
#define XB_XGEN(j)  (2304 + 64 * (j))
#define XB_TOP      3328
#define XB_TOPGEN   3392
#define XCD_BAR_WORDS 3456
#define XB_SPIN_CAP (1u << 20)
__device__ __forceinline__ unsigned xb_ld(unsigned* p)              { return __hip_atomic_load(p, __ATOMIC_RELAXED, __HIP_MEMORY_SCOPE_AGENT); }
__device__ __forceinline__ unsigned xb_add(unsigned* p, unsigned v) { return __hip_atomic_fetch_add(p, v, __ATOMIC_RELAXED, __HIP_MEMORY_SCOPE_AGENT); }
__device__ __forceinline__ unsigned xb_xcc_id() { return (unsigned)__builtin_amdgcn_s_getreg((3 << 11) | 20) & 0xFu; }
#define XB_SPIN(cond, bar) do { unsigned _sp = 0; while (cond) { __builtin_amdgcn_s_sleep(1); \
    if ((++_sp & 255u) == 0u) { if (xb_ld(&(bar)[XB_TMO])) break; if (_sp > XB_SPIN_CAP) { atomicAdd(&(bar)[XB_TMO], 1u); break; } } } } while (0)
struct XcdBarrier { unsigned* bar; unsigned x; volatile LAS unsigned* st; };
__device__ __forceinline__ XcdBarrier xcd_barrier_post(unsigned* bar, volatile LAS unsigned* st) {
    XcdBarrier b; b.bar = bar; b.x = xb_xcc_id(); b.st = st;
    if (threadIdx.x == 0) (void)xb_add(&bar[XB_XCNT(b.x)], 1u);
    return b;
}
__device__ __forceinline__ void xcd_barrier_complete(unsigned* bar, unsigned x, unsigned& nloc, unsigned& nx) {
    const unsigned G = gridDim.x * gridDim.y * gridDim.z;
    unsigned sum, cnt, mine, sp = 0u;
    for (;;) {
        sum = 0u; cnt = 0u; mine = 0u;
#pragma unroll
        for (unsigned j = 0; j < 16; ++j) { const unsigned c = xb_ld(&bar[XB_XCNT(j)]); sum += c; cnt += (c > 0u) ? 1u : 0u; mine = (j == x) ? c : mine; }
        if (sum == G) break;
        __builtin_amdgcn_s_sleep(1);
        if ((++sp & 255u) == 0u) { if (xb_ld(&bar[XB_TMO])) break; if (sp > XB_SPIN_CAP) { atomicAdd(&bar[XB_TMO], 1u); break; } }
    }
    nloc = mine > 0u ? mine : 1u; nx = cnt > 0u ? cnt : 1u;
}
__device__ __forceinline__ void xcd_barrier(const XcdBarrier& b) {
    asm volatile("s_waitcnt vmcnt(0)" ::: "memory");
    __syncthreads();
    if (threadIdx.x == 0) {
        unsigned* bar = b.bar;
        __builtin_amdgcn_s_waitcnt(0);
        unsigned nloc = b.st[0], nx = b.st[1];
        if (nloc == 0u) { xcd_barrier_complete(bar, b.x, nloc, nx); b.st[0] = nloc; b.st[1] = nx; }
        const unsigned old = xb_add(&bar[XB_XSUB(b.x)], 1u);
        const unsigned gen = old / nloc;
        if (old + 1u == (gen + 1u) * nloc) {
            __builtin_amdgcn_fence(__ATOMIC_RELEASE, "agent");
            asm volatile("s_waitcnt vmcnt(0)" ::: "memory");
            const unsigned og = xb_add(&bar[XB_TOP], 1u);
            const unsigned tg = og / nx;
            if (og + 1u == (tg + 1u) * nx) xb_add(&bar[XB_TOPGEN], 1u);
            else XB_SPIN(xb_ld(&bar[XB_TOPGEN]) == tg, bar);
            __builtin_amdgcn_fence(__ATOMIC_ACQUIRE, "agent");
            xb_add(&bar[XB_XGEN(b.x)], 1u);
            asm volatile("s_waitcnt vmcnt(0)" ::: "memory");
        } else {
            XB_SPIN(xb_ld(&bar[XB_XGEN(b.x)]) == gen, bar);
            __builtin_amdgcn_fence(__ATOMIC_ACQUIRE, "agent");
            asm volatile("s_waitcnt vmcnt(0)" ::: "memory");
        }
    }
    __syncthreads();
}

struct Args {
    const float* in[28]; float* out; unsigned char* ws; int ph_lo, ph_hi;
};
#define LDS_WAIT() asm volatile("s_waitcnt lgkmcnt(0)" ::: "memory")

__device__ __forceinline__ float wave_sum(float v) {
#pragma unroll
    for (int o = 1; o < 64; o <<= 1) v += __shfl_xor(v, o);
    return v;
}

__device__ __forceinline__ void transpose_item(const float* W, int N, bf16_t* WT, int K, int drow0, const float* gain, LAS float* scr, int k0, int n0, int lane) {
    const int l15 = lane & 15, q = lane >> 4;
    f32x4 v[16];
#pragma unroll
    for (int i = 0; i < 16; ++i) v[i] = *(const f32x4*)(W + (size_t)(k0 + 4 * i + q) * N + n0 + 4 * l15);
#pragma unroll
    for (int i = 0; i < 16; ++i) { const int kk = 4 * i + q; const float gsc = gain ? gain[k0 + kk] : 1.0f; LAS float* d = scr + kk * 65 + 4 * l15;
        d[0] = v[i][0] * gsc; d[1] = v[i][1] * gsc; d[2] = v[i][2] * gsc; d[3] = v[i][3] * gsc; }
    LDS_WAIT(); asm volatile("" ::: "memory");
    const int c = lane & 7;
#pragma unroll
    for (int j = 0; j < 8; ++j) { const int n = (lane >> 3) + 8 * j; const LAS float* sp = scr + (8 * c) * 65 + n;
        u32x4 o; o.x = cvt_pk_bf16(sp[0 * 65], sp[1 * 65]); o.y = cvt_pk_bf16(sp[2 * 65], sp[3 * 65]); o.z = cvt_pk_bf16(sp[4 * 65], sp[5 * 65]); o.w = cvt_pk_bf16(sp[6 * 65], sp[7 * 65]);
        *(u32x4*)(WT + (size_t)(drow0 + n) * K + k0 + 8 * c) = o; }
    LDS_WAIT(); asm volatile("" ::: "memory");
}
__device__ __forceinline__ int pair_lo(int n) { return 256 * (n >> 7) + (n & 127); }
__device__ __forceinline__ int pair_hi(int n) { return 256 * (n >> 7) + 128 + (n & 127); }
constexpr int IT_GU = (D / 64) * (FF / 64), IT_DN = (FF / 64) * (D / 64), IT_FFN = 2 * IT_GU + IT_DN;
__device__ __forceinline__ void conv_ffn_item(int r, const float* wg, const float* wu, const float* wd, const float* gain, bf16_t* WGU, bf16_t* WDt, LAS float* scr, int lane) {
    if (r < IT_GU) { const int kb = r / (FF / 64), nb = r % (FF / 64); transpose_item(wg, FF, WGU, D, pair_lo(64 * nb), gain, scr, 64 * kb, 64 * nb, lane); return; } r -= IT_GU;
    if (r < IT_GU) { const int kb = r / (FF / 64), nb = r % (FF / 64); transpose_item(wu, FF, WGU, D, pair_hi(64 * nb), gain, scr, 64 * kb, 64 * nb, lane); return; } r -= IT_GU;
    { const int kb = r / (D / 64), nb = r % (D / 64); transpose_item(wd, D, WDt, FF, 64 * nb, nullptr, scr, 64 * kb, 64 * nb, lane); }
}

constexpr int IT_WIN = (D / 64) * (NIN / 64), IT_CO = (D / 64) * (D / 64), IT_GLU = (D / 64) * (2 * D / 64), IT_O = IT_CO;
constexpr int ITB_FFN2 = IT_FFN, ITB_WIN = 2 * IT_FFN, ITB_CO = ITB_WIN + IT_WIN, ITB_GLU = ITB_CO + IT_CO, ITB_O = ITB_GLU + IT_GLU, ITB_END = ITB_O + IT_O;
__device__ __forceinline__ void conv_range(const Args& a, LAS unsigned char* lds, int lo, int hi, int idx, int n, int wave, int lane) {
    unsigned char* ws = a.ws; LAS float* scr = (LAS float*)(lds + wave * 16896);
    bf16_t* WGU = (bf16_t*)(ws + WS_WGU); bf16_t* WDt = (bf16_t*)(ws + WS_WD); bf16_t* WIN = (bf16_t*)(ws + WS_WIN); bf16_t* WCO = (bf16_t*)(ws + WS_WCO); bf16_t* WGLU = (bf16_t*)(ws + WS_WGLU); bf16_t* WOt = (bf16_t*)(ws + WS_WO);
    bf16_t* WGU1 = (bf16_t*)a.out; bf16_t* WD1 = WGU1 + (size_t)2 * FF * D;
    for (int it = lo + idx; it < hi; it += n) {
        int r = it;
        if (r < IT_FFN) { conv_ffn_item(r, a.in[6], a.in[7], a.in[8], a.in[5], WGU1, WD1, scr, lane); continue; } r -= IT_FFN;
        if (r < IT_FFN) { conv_ffn_item(r, a.in[24], a.in[25], a.in[26], a.in[23], WGU, WDt, scr, lane); continue; } r -= IT_FFN;
        if (r < IT_WIN) { const int kb = r / (NIN / 64), nb = r % (NIN / 64), n0 = 64 * nb; const int dr = n0 < 1024 ? pair_lo(n0) : (n0 < 2048 ? pair_hi(n0 - 1024) : n0);
            transpose_item(a.in[10], NIN, WIN, D, dr, a.in[9], scr, 64 * kb, n0, lane); continue; } r -= IT_WIN;
        if (r < IT_CO) { const int kb = r / (D / 64), nb = r % (D / 64); transpose_item(a.in[12], D, WCO, D, 64 * nb, nullptr, scr, 64 * kb, 64 * nb, lane); continue; } r -= IT_CO;
        if (r < IT_GLU) { const int kb = r / (2 * D / 64), nb = r % (2 * D / 64), n0 = 64 * nb; const int dr = n0 < 1024 ? pair_lo(n0) : pair_hi(n0 - 1024);
            transpose_item(a.in[21], 2 * D, WGLU, D, dr, nullptr, scr, 64 * kb, n0, lane); continue; } r -= IT_GLU;
        { const int kb = r / (D / 64), nb = r % (D / 64); transpose_item(a.in[22], D, WOt, D, 64 * nb, nullptr, scr, 64 * kb, 64 * nb, lane); }
    }
}

typedef float cplx __attribute__((ext_vector_type(2)));
#define CX(a, b) ((cplx){(a), (b)})
__device__ __forceinline__ cplx cmul(cplx a, cplx b) { return CX(a.x * b.x - a.y * b.y, a.x * b.y + a.y * b.x); }
__device__ __forceinline__ cplx cfma(cplx a, cplx b, cplx c) { return CX(fmaf(a.x, b.x, fmaf(-a.y, b.y, c.x)), fmaf(a.x, b.y, fmaf(a.y, b.x, c.y))); }

__device__ __forceinline__ void ssm_tables_job(const Args& a, LAS unsigned char* lds, int g, int part, int tid) {
    LAS cplx* pw = (LAS cplx*)lds;
    LAS cplx* bb = pw + 17 * 64;
    LAS cplx* cc = bb + 64 * 16;
    LAS float* kt = (LAS float*)(cc + 16 * 64);
    const float* lam_re = a.in[13] + g * NP; const float* lam_im = a.in[14] + g * NP; const float stepv = expf(a.in[15][g]);
    const float* b_re = a.in[16] + (size_t)g * NP * 16; const float* b_im = a.in[17] + (size_t)g * NP * 16;
    const float* c_re = a.in[18] + (size_t)g * 16 * NP; const float* c_im = a.in[19] + (size_t)g * 16 * NP; const float* dsk = a.in[20] + g * 16;
    unsigned char* ws = a.ws;
    for (int idx = tid; idx < 17 * 64; idx += 512) { const int tau = idx >> 6, p = idx & 63;
        const float zr = (float)tau * stepv * lam_re[p]; const double zt = (double)tau * (double)stepv * (double)lam_im[p] * 0.15915494309189535;
        const float rt = (float)(zt - rint(zt));
        const float mag = __builtin_amdgcn_exp2f(zr * 1.4426950409f); pw[idx] = CX(mag * __builtin_amdgcn_cosf(rt), mag * __builtin_amdgcn_sinf(rt)); }
    for (int idx = tid; idx < 64 * 16; idx += 512) { const int p = idx >> 4;
        const float lr = lam_re[p], li = lam_im[p], zr = stepv * lr; const double zt = (double)stepv * (double)li * 0.15915494309189535; const float rt = (float)(zt - rint(zt));
        const float ex1 = zr * (1.0f + zr * (0.5f + zr * (0.16666667f + zr * (0.041666668f + zr * 0.0083333338f))));
        const float sn = __builtin_amdgcn_sinf(rt), cs = __builtin_amdgcn_cosf(rt), sh = __builtin_amdgcn_sinf(0.5f * rt);
        const float nr = ex1 * cs - 2.0f * sh * sh, ni = (ex1 + 1.0f) * sn;
        const float den = 1.0f / (lr * lr + li * li); const cplx q = CX((nr * lr + ni * li) * den, (ni * lr - nr * li) * den);
        bb[idx] = cmul(q, CX(b_re[idx], b_im[idx])); }
    for (int idx = tid; idx < 16 * 64; idx += 512) cc[idx] = CX(c_re[idx], c_im[idx]);
    __syncthreads();
    {
        bf16_t* W1T = (bf16_t*)(ws + WS_W1T) + (size_t)g * 32768;
        for (int o8 = part * 1024 + tid; o8 < part * 1024 + 1024; o8 += 512) { const int lane = o8 & 63, nt = (o8 >> 6) & 7, ks = o8 >> 9; const int n = nt * 16 + (lane & 15), p = n & 63, isim = n >> 6; float v[8];
#pragma unroll
            for (int jj = 0; jj < 8; ++jj) { const int kk = ks * 32 + 8 * (lane >> 4) + jj, j = kk >> 4, c1 = kk & 15; const cplx pr = cmul(pw[(15 - j) * 64 + p], bb[p * 16 + c1]); v[jj] = isim ? pr.y : pr.x; }
            u32x4 w; w.x = cvt_pk_bf16(v[0], v[1]); w.y = cvt_pk_bf16(v[2], v[3]); w.z = cvt_pk_bf16(v[4], v[5]); w.w = cvt_pk_bf16(v[6], v[7]);
            *(u32x4*)(W1T + (size_t)o8 * 8) = w; }
        bf16_t* W3T = (bf16_t*)(ws + WS_W3T) + (size_t)g * 32768;
        for (int o8 = part * 1024 + tid; o8 < part * 1024 + 1024; o8 += 512) { const int lane = o8 & 63, i = (o8 >> 6) & 15, ks = o8 >> 10; const int c = lane & 15; float v[8];
#pragma unroll
            for (int jj = 0; jj < 8; ++jj) { const int k = ks * 32 + 8 * (lane >> 4) + jj, p = k & 63, isim = k >> 6; const cplx cl = cmul(cc[c * 64 + p], pw[(i + 1) * 64 + p]); v[jj] = isim ? -cl.y : cl.x; }
            u32x4 w; w.x = cvt_pk_bf16(v[0], v[1]); w.y = cvt_pk_bf16(v[2], v[3]); w.z = cvt_pk_bf16(v[4], v[5]); w.w = cvt_pk_bf16(v[6], v[7]);
            *(u32x4*)(W3T + (size_t)o8 * 8) = w; }
        float* KT = (float*)(ws + WS_TOEP) + (size_t)g * 4096;
        for (int idx = part * 1024 + tid; idx < part * 1024 + 1024; idx += 512) { const int tau = idx >> 8, c = (idx >> 4) & 15, c1 = idx & 15; float sa = 0.f, sb = 0.f;
#pragma unroll 8
            for (int p = 0; p < 64; p += 2) { const cplx t0 = cmul(cc[c * 64 + p], pw[tau * 64 + p]), b0 = bb[p * 16 + c1], t1 = cmul(cc[c * 64 + p + 1], pw[tau * 64 + p + 1]), b1 = bb[(p + 1) * 16 + c1];
                sa += t0.x * b0.x - t0.y * b0.y; sb += t1.x * b1.x - t1.y * b1.y; }
            float sv = sa + sb; if (tau == 0 && c == c1) sv += dsk[c];
            KT[idx] = sv; }
        if (part == 0 && tid < 64) ((cplx*)(ws + WS_LAM))[g * 64 + tid] = pw[16 * 64 + tid];
    }
    __syncthreads();
}

constexpr int L_US = 0, L_SL = 67584, L_SIN = 101376, L_TOEP = 118784, L_ASEG = 135168, L_CARRY = 139264;
struct SsmFrags { bf16x8 w1[8]; bf16x8 w3[2][4]; cplx lam; };
#define LBAR() do { asm volatile("s_waitcnt lgkmcnt(0)" ::: "memory"); __builtin_amdgcn_s_barrier(); asm volatile("" ::: "memory"); } while (0)
template <bool SAMPLE>
__device__ __forceinline__ void ssm_tile(const Args& a, LAS unsigned char* lds, int g, int row0, int tile, bool first, bool last, int seq, const SsmFrags& F, bool has_next_tile, int tid, bf16_t* Yg) {
    const int wid = __builtin_amdgcn_readfirstlane(tid >> 6), lane = tid & 63, l15 = lane & 15, q = lane >> 4;
    unsigned char* ws = a.ws;
    bf16_t* Ug = (bf16_t*)(ws + WS_R + 2 * SLOT) + ((size_t)g * M + row0) * 16;
    const int ub = L_US + (tile & 1) * 33792, ubn = L_US + ((tile + 1) & 1) * 33792;
    u32x4 pf[4];
    if (has_next_tile) {
#pragma unroll
        for (int k = 0; k < 4; ++k) pf[k] = ((const u32x4*)(Ug + 16384))[tid + 512 * k]; }
#pragma unroll
    for (int rb = 0; rb < 4; ++rb) { f32x4 acc = {0.f, 0.f, 0.f, 0.f};
#pragma unroll
        for (int ks = 0; ks < 8; ++ks) { const bf16x8 av = *(const LAS bf16x8*)(lds + ub + (rb * 16 + l15) * 528 + ks * 64 + q * 16); acc = __builtin_amdgcn_mfma_f32_16x16x32_bf16(F.w1[ks], av, acc, 0, 0, 0); }
        *(LAS f32x4*)(lds + L_SL + ((rb * 16 + l15) * 132 + wid * 16 + q * 4) * 4) = acc; }
    LBAR();
    {
        const int p = lane, seg = wid; const LAS float* Sl = (const LAS float*)(lds + L_SL); LAS bf16_t* Sin = (LAS bf16_t*)(lds + L_SIN);
        const cplx L1 = F.lam;
        if (!SAMPLE) {
            LAS cplx* Aseg = (LAS cplx*)(lds + L_ASEG); LAS cplx* carry = (LAS cplx*)(lds + L_CARRY);
            cplx sv[8];
#pragma unroll
            for (int c = 0; c < 8; ++c) { const int ch = seg * 8 + c; sv[c] = CX(Sl[ch * 132 + p], Sl[ch * 132 + 64 + p]); }
            cplx acc = CX(0.f, 0.f);
#pragma unroll
            for (int c = 0; c < 8; ++c) acc = cfma(L1, acc, sv[c]);
            Aseg[seg * 64 + p] = acc;
            LBAR();
            const cplx L2 = cmul(L1, L1), L4 = cmul(L2, L2), L8 = cmul(L4, L4);
            cplx x = first ? CX(0.f, 0.f) : carry[(tile & 1) * 64 + p];
            for (int s = 0; s < seg; ++s) x = cfma(L8, x, Aseg[s * 64 + p]);
#pragma unroll
            for (int c = 0; c < 8; ++c) { const int ch = seg * 8 + c; Sin[ch * 136 + p] = (bf16_t)(cvt_pk_bf16(x.x, 0.f) & 0xffffu); Sin[ch * 136 + 64 + p] = (bf16_t)(cvt_pk_bf16(x.y, 0.f) & 0xffffu);
                x = cfma(L1, x, sv[c]); }
            if (seg == 7) { carry[((tile + 1) & 1) * 64 + p] = x;
                if (last) { a.out[O_SREP + ((size_t)seq * NG + g) * NP + p] = x.x; a.out[O_SIMP + ((size_t)seq * NG + g) * NP + p] = x.y; } }
        } else {
#pragma unroll
            for (int sq = 0; sq < 4; ++sq) { const int s = seg * 4 + sq; const size_t so = ((size_t)s * NG + g) * NP + p;
                cplx x = CX(a.in[3][so], a.in[4][so]);
#pragma unroll
                for (int c = 0; c < 2; ++c) { const int ch = 2 * s + c; Sin[ch * 136 + p] = (bf16_t)(cvt_pk_bf16(x.x, 0.f) & 0xffffu); Sin[ch * 136 + 64 + p] = (bf16_t)(cvt_pk_bf16(x.y, 0.f) & 0xffffu);
                    x = cfma(L1, x, CX(Sl[ch * 132 + p], Sl[ch * 132 + 64 + p])); }
                a.out[O_SRES + so] = x.x; a.out[O_SIMS + so] = x.y; }
        }
    }
    LBAR();
    {
        f32x4 acc[2][4];
#pragma unroll
        for (int t2 = 0; t2 < 2; ++t2)
#pragma unroll
            for (int rb = 0; rb < 4; ++rb) acc[t2][rb] = (f32x4){0.f, 0.f, 0.f, 0.f};
#pragma unroll
        for (int ks = 0; ks < 4; ++ks)
#pragma unroll
            for (int rb = 0; rb < 4; ++rb) { const bf16x8 av = *(const LAS bf16x8*)(lds + L_SIN + (rb * 16 + l15) * 272 + ks * 64 + q * 16);
                acc[0][rb] = __builtin_amdgcn_mfma_f32_16x16x32_bf16(F.w3[0][ks], av, acc[0][rb], 0, 0, 0); acc[1][rb] = __builtin_amdgcn_mfma_f32_16x16x32_bf16(F.w3[1][ks], av, acc[1][rb], 0, 0, 0); }
#pragma unroll
        for (int t2 = 0; t2 < 2; ++t2) { const int i = t2 ? 15 - wid : wid; const int ns = (i >> 1) + 1;
            bf16x8 bfc = *(const LAS bf16x8*)(lds + L_TOEP + (i * 64 + lane) * 16); bf16x8 avc[4];
#pragma unroll
            for (int rb = 0; rb < 4; ++rb) avc[rb] = *(const LAS bf16x8*)(lds + ub + (rb * 16 + l15) * 528 + q * 16);
            for (int s2 = 0; s2 < ns; ++s2) { const int sn = (s2 + 1 < ns) ? s2 + 1 : s2;
                const bf16x8 bfn = *(const LAS bf16x8*)(lds + L_TOEP + ((i - 2 * sn) * 64 + lane) * 16); bf16x8 avn[4];
#pragma unroll
                for (int rb = 0; rb < 4; ++rb) avn[rb] = *(const LAS bf16x8*)(lds + ub + (rb * 16 + l15) * 528 + sn * 64 + q * 16);
#pragma unroll
                for (int rb = 0; rb < 4; ++rb) acc[t2][rb] = __builtin_amdgcn_mfma_f32_16x16x32_bf16(bfc, avc[rb], acc[t2][rb], 0, 0, 0);
                bfc = bfn;
#pragma unroll
                for (int rb = 0; rb < 4; ++rb) avc[rb] = avn[rb]; }
#pragma unroll
            for (int rb = 0; rb < 4; ++rb) { u32x2 w; w.x = cvt_pk_bf16(gelu_tanh_f(acc[t2][rb][0]), gelu_tanh_f(acc[t2][rb][1])); w.y = cvt_pk_bf16(gelu_tanh_f(acc[t2][rb][2]), gelu_tanh_f(acc[t2][rb][3]));
                *(LAS u32x2*)(lds + L_SL + (rb * 16 + l15) * 528 + i * 32 + q * 8) = w; } }
    }
    LBAR();
#pragma unroll
    for (int k = 0; k < 4; ++k) { const int i = tid + 512 * k; const u32x4 v = *(const LAS u32x4*)(lds + L_SL + (i >> 5) * 528 + (i & 31) * 16); ((u32x4*)Yg)[i] = v; }
    if (has_next_tile) {
#pragma unroll
        for (int k = 0; k < 4; ++k) { const int i = tid + 512 * k; *(LAS u32x4*)(lds + ubn + (i >> 5) * 528 + (i & 31) * 16) = pf[k]; } }
    LBAR();
}
__device__ __forceinline__ void ssm_item_begin(const Args& a, LAS unsigned char* lds, int g, int row0, SsmFrags& F, int tid) {
    const int wid = __builtin_amdgcn_readfirstlane(tid >> 6), lane = tid & 63;
    unsigned char* ws = a.ws;
    const bf16_t* W1T = (const bf16_t*)(ws + WS_W1T) + (size_t)g * 32768; const bf16_t* W3T = (const bf16_t*)(ws + WS_W3T) + (size_t)g * 32768;
    const bf16_t* Ug = (const bf16_t*)(ws + WS_R + 2 * SLOT) + ((size_t)g * M + row0) * 16;
    u32x4 uv[4]; f32x4 ka[2][2];
#pragma unroll
    for (int k = 0; k < 4; ++k) uv[k] = ((const u32x4*)Ug)[tid + 512 * k];
    const float* KT = (const float*)(ws + WS_TOEP) + (size_t)g * 4096;
#pragma unroll
    for (int k = 0; k < 2; ++k) { const int o8 = tid + 512 * k, ln = o8 & 63, d = o8 >> 6, qq = ln >> 4, dd = d - (qq >> 1); const float* src = KT + (dd < 0 ? 0 : dd) * 256 + (ln & 15) * 16 + 8 * (qq & 1);
        ka[k][0] = *(const f32x4*)src; ka[k][1] = *(const f32x4*)(src + 4); if (dd < 0) { ka[k][0] = (f32x4){0.f, 0.f, 0.f, 0.f}; ka[k][1] = (f32x4){0.f, 0.f, 0.f, 0.f}; } }
#pragma unroll
    for (int ks = 0; ks < 8; ++ks) F.w1[ks] = *(const bf16x8*)(W1T + ((size_t)(ks * 8 + wid) * 64 + lane) * 8);
#pragma unroll
    for (int t2 = 0; t2 < 2; ++t2) { const int i = t2 ? 15 - wid : wid;
#pragma unroll
        for (int ks = 0; ks < 4; ++ks) F.w3[t2][ks] = *(const bf16x8*)(W3T + ((size_t)(ks * 16 + i) * 64 + lane) * 8); }
    F.lam = ((const cplx*)(ws + WS_LAM))[g * 64 + lane];
#pragma unroll
    for (int k = 0; k < 4; ++k) { const int i = tid + 512 * k; *(LAS u32x4*)(lds + L_US + (i >> 5) * 528 + (i & 31) * 16) = uv[k]; }
#pragma unroll
    for (int k = 0; k < 2; ++k) { u32x4 w; w.x = cvt_pk_bf16(ka[k][0][0], ka[k][0][1]); w.y = cvt_pk_bf16(ka[k][0][2], ka[k][0][3]); w.z = cvt_pk_bf16(ka[k][1][0], ka[k][1][1]); w.w = cvt_pk_bf16(ka[k][1][2], ka[k][1][3]);
        *(LAS u32x4*)(lds + L_TOEP + (tid + 512 * k) * 16) = w; }
    LDS_WAIT(); __syncthreads();
}

typedef float f32x8 __attribute__((ext_vector_type(8)));
__device__ __forceinline__ f32x8 bf8_to_f32(u32x4 v) { return (f32x8){bf_lo(v.x), bf_hi(v.x), bf_lo(v.y), bf_hi(v.y), bf_lo(v.z), bf_hi(v.z), bf_lo(v.w), bf_hi(v.w)}; }
__device__ __forceinline__ f32x8 ld_f32x8(const float* p) { const f32x4 a = *(const f32x4*)p, b = *(const f32x4*)(p + 4); return (f32x8){a[0], a[1], a[2], a[3], b[0], b[1], b[2], b[3]}; }
template <int NR>
__device__ __forceinline__ void conv_rows(const float* cstate, const bf16_t* Z, const bf16_t* BG, bf16_t* ZC, int r0, int c0, f32x8 w0, f32x8 w1, f32x8 w2, f32x8& z1, f32x8& z2) {
    u32x4 zv[NR], bv[NR];
#pragma unroll
    for (int rr = 0; rr < NR; ++rr) { zv[rr] = *(const u32x4*)(Z + (size_t)(r0 + rr) * D + c0); bv[rr] = *(const u32x4*)(BG + (size_t)(r0 + rr) * D + c0); }
#pragma unroll
    for (int rr = 0; rr < NR; ++rr) { const int row = r0 + rr;
        const bool st = (row < MP) ? ((row & 4095) == 0) : (((row - MP) & 31) == 0);
        if (st) { if (row < MP) { z1 = (f32x8)(0.f); z2 = (f32x8)(0.f); }
            else { const int s = (row - MP) >> 5; const float* pv = cstate + (size_t)s * 2 * D + c0; z2 = ld_f32x8(pv); z1 = ld_f32x8(pv + D); } }
        const f32x8 z0 = bf8_to_f32(zv[rr]), b0 = bf8_to_f32(bv[rr]);
        const f32x8 o = b0 * (w0 * z2 + w1 * z1 + w2 * z0); z2 = z1; z1 = z0;
        u32x4 w; w.x = cvt_pk_bf16(o[0], o[1]); w.y = cvt_pk_bf16(o[2], o[3]); w.z = cvt_pk_bf16(o[4], o[5]); w.w = cvt_pk_bf16(o[6], o[7]);
        *(u32x4*)(ZC + (size_t)row * D + c0) = w; }
}

constexpr int NPHASE = 10;
__global__ void __launch_bounds__(512, 2) mk_fwd(Args a) {
    extern __shared__ __attribute__((aligned(16))) unsigned char lds_raw[];
    LAS unsigned char* lds = (LAS unsigned char*)lds_raw;
    const int tid = threadIdx.x, lane = tid & 63, wave = __builtin_amdgcn_readfirstlane(tid >> 6);
    const int G = gridDim.x; const int bx = blockIdx.x; const int vcu = (G % 8 == 0) ? (bx % 8) * (G / 8) + bx / 8 : bx;
    unsigned char* ws = a.ws;
    volatile LAS unsigned* MISC = (volatile LAS unsigned*)(lds + LDSCTL_OFF);
    if (tid < 64) MISC[tid] = 0u;
    __syncthreads();
    XcdBarrier bar; bar.bar = (unsigned*)(ws + WS_CTL) + CW_BAR; bar.x = 0; bar.st = nullptr;
    const int lo = a.ph_lo, hi = a.ph_hi;
    if (hi - lo > 1) bar = xcd_barrier_post((unsigned*)(ws + WS_CTL) + CW_BAR, MISC + 8);
#define IN(k) (lo <= (k) && (k) < hi)
#define SEAM(k) do { if (IN(k) && IN((k) + 1)) xcd_barrier(bar); } while (0)
#ifndef DUP_PHASE
#define DUP_PHASE -1
#endif
#define REPS(k) ((DUP_PHASE) == (k) ? 2 : 1)
#define REP(k) for (int rep_ = 0; rep_ < REPS(k); ++rep_, (rep_ < REPS(k) ? xcd_barrier(bar) : (void)0))

    bf16_t* WGU = (bf16_t*)(ws + WS_WGU); bf16_t* WDt = (bf16_t*)(ws + WS_WD); bf16_t* WIN = (bf16_t*)(ws + WS_WIN); bf16_t* WCO = (bf16_t*)(ws + WS_WCO);
    bf16_t* WGLU = (bf16_t*)(ws + WS_WGLU); bf16_t* WOt = (bf16_t*)(ws + WS_WO); bf16_t* XA = (bf16_t*)(ws + WS_XA);
    bf16_t* R0 = (bf16_t*)(ws + WS_R); bf16_t* R1 = (bf16_t*)(ws + WS_R + SLOT); bf16_t* R2 = (bf16_t*)(ws + WS_R + 2 * SLOT); bf16_t* R3 = (bf16_t*)(ws + WS_R + 3 * SLOT); bf16_t* R4 = (bf16_t*)(ws + WS_R + 4 * SLOT);
    bf16_t* HB = R0;
    bf16_t* WGU1 = (bf16_t*)a.out; bf16_t* WD1 = WGU1 + (size_t)2 * FF * D;
    float* ss0 = (float*)(ws + WS_SS); float* ss1 = (float*)(ws + WS_SS + SS_BYTES); float* ss2 = (float*)(ws + WS_SS + 2 * SS_BYTES); float* ss3 = (float*)(ws + WS_SS + 3 * SS_BYTES);
    float* Y = a.out + O_Y;
    u32x2* PD2 = (u32x2*)((unsigned char*)a.out + 17 * MiB); u32x2* PDO = (u32x2*)a.out; u32x2* PD9 = (u32x2*)(ws + WS_XA);
    const int gw = vcu * 8 + wave, NGW = G * 8;

    if (IN(0)) REP(0) {
        const bool tables_first = (bx & 1) != 0;
        if (tables_first) for (int job = vcu; job < NG * 4; job += G) ssm_tables_job(a, lds, job >> 2, job & 3, tid);
        conv_range(a, lds, 0, 2 * IT_GU, gw, NGW, wave, lane);
        for (int m0 = gw; m0 < M; m0 += 4 * NGW) {
            f32x4 v[4][4]; int mr[4];
#pragma unroll
            for (int r = 0; r < 4; ++r) { const int m = m0 + r * NGW; mr[r] = m < M ? m : m0; const float* xr = (mr[r] < MP) ? a.in[0] + (size_t)mr[r] * D : a.in[1] + (size_t)(mr[r] - MP) * D;
#pragma unroll
                for (int j = 0; j < 4; ++j) v[r][j] = ((const f32x4*)xr)[lane + 64 * j]; }
#pragma unroll
            for (int r = 0; r < 4; ++r) { if (r > 0 && m0 + r * NGW >= M) break; float sq = 0.f;
#pragma unroll
                for (int j = 0; j < 4; ++j) sq += (v[r][j][0] * v[r][j][0] + v[r][j][1] * v[r][j][1]) + (v[r][j][2] * v[r][j][2] + v[r][j][3] * v[r][j][3]);
                sq = wave_sum(sq);
#pragma unroll
                for (int j = 0; j < 4; ++j) { u32x2 w; w.x = cvt_pk_bf16(v[r][j][0], v[r][j][1]); w.y = cvt_pk_bf16(v[r][j][2], v[r][j][3]); ((u32x2*)(XA + (size_t)mr[r] * D))[lane + 64 * j] = w; }
                if (lane == 0) *(f32x4*)(ss0 + (size_t)mr[r] * 4) = (f32x4){sq, 0.f, 0.f, 0.f}; }
        }
        __syncthreads();
        if (!tables_first) for (int job = vcu; job < NG * 4; job += G) ssm_tables_job(a, lds, job >> 2, job & 3, tid);
    }
    SEAM(0);
    if (IN(1)) REP(1) { pg8::Gemm g{XA, WGU1, M, 2 * FF, D, 2 * D, 32}; pg8::StaticOrder S; S.init(M, 2 * FF, D, G, bx, 1); pg8::EpiSwiGLU E{HB, ss0}; pg8::gemm_phase<false>(lds, g, S, E, nullptr, nullptr);
        if (S.r > 0 && bx >= S.r) { const int nw = (G - S.r) * 8; conv_range(a, lds, 2 * IT_GU, IT_FFN, (bx - S.r) * 8 + wave, nw, wave, lane); __syncthreads(); } }
    SEAM(1);
    if (IN(2)) REP(2) { pg8::Gemm g{HB, WD1, M, D, FF, 2 * FF, 32}; pg8::StaticOrder S; S.init(M, D, FF, G, bx, NSPLIT); pg8::EpiResid<true, false, true> E{nullptr, nullptr, XA, nullptr, XA, ss1, 0.5f};   pg8::gemm_phase<true>(lds, g, S, E, PD2, (unsigned*)(ws + WS_CTL) + CW_CNT + 0 * 2048);
        { const int nt_ = S.ns > 1 ? S.r * S.ns : 0; if (bx >= nt_ && nt_ < G) { const int nw = (G - nt_) * 8; conv_range(a, lds, ITB_WIN, ITB_END, (bx - nt_) * 8 + wave, nw, wave, lane); __syncthreads(); } } }
    SEAM(2);
    if (IN(3)) { pg8::Gemm g{XA, WIN, M, NIN, D, 2 * D, 32}; pg8::ZFirstOrder S; unsigned* zdone = (unsigned*)(ws + WS_CTL) + CW_ZF; S.init(G, bx, zdone);
        pg8::EpiMixIn E{R0, R1, R2, (unsigned char*)R3, (unsigned char*)R4, ss1, a.out};
        pg8::gemm_phase<false>(lds, g, S, E, nullptr, nullptr);
        const int ntot = S.nA + S.nB, rlast = ntot - ((ntot - 1) / G) * G;
        const bool all_conv = (rlast == G);
        if (all_conv || bx >= rlast) {
            if (tid == 0) { unsigned sp = 0; while (__hip_atomic_load(zdone, __ATOMIC_RELAXED, __HIP_MEMORY_SCOPE_AGENT) < (unsigned)S.publishers()) { __builtin_amdgcn_s_sleep(2); if (++sp > (1u << 22)) break; }
                __builtin_amdgcn_fence(__ATOMIC_ACQUIRE, "agent"); asm volatile("s_waitcnt vmcnt(0)" ::: "memory"); }
            __syncthreads();
            const int cw = all_conv ? bx : bx - rlast, ncw = all_conv ? G : G - rlast, nruns = ncw * 4;
            const float* wc = a.in[11]; const float* cstate = a.in[2]; const bf16_t* Z = R0; bf16_t* BG = R1;
            const int run = cw * 4 + (tid >> 7), c0 = (tid & 127) * 8;
            const int r0 = (int)(((long)run * M) / nruns), r1 = (int)(((long)(run + 1) * M) / nruns);
            const f32x8 w0 = ld_f32x8(wc + c0), w1 = ld_f32x8(wc + D + c0), w2 = ld_f32x8(wc + 2 * D + c0); f32x8 z1 = (f32x8)(0.f), z2 = (f32x8)(0.f);
            { const bool st = (r0 < MP) ? ((r0 & 4095) == 0) : (((r0 - MP) & 31) == 0);
              if (!st) { const bool st1 = (r0 < MP) ? (((r0 - 1) & 4095) == 0) : (((r0 - 1 - MP) & 31) == 0);
                  z1 = bf8_to_f32(*(const u32x4*)(Z + (size_t)(r0 - 1) * D + c0));
                  if (!st1) z2 = bf8_to_f32(*(const u32x4*)(Z + (size_t)(r0 - 2) * D + c0));
                  else if (r0 - 1 >= MP) { const int sq = (r0 - 1 - MP) >> 5; z2 = ld_f32x8(cstate + ((size_t)sq * 2 + 1) * D + c0); } } }
            int r = r0;
            for (; r + 9 <= r1; r += 9) { int rr = r; asm volatile("" : "+v"(rr)); conv_rows<9>(cstate, Z, BG, BG, rr, c0, w0, w1, w2, z1, z2); }
            for (; r + 4 <= r1; r += 4) { int rr = r; asm volatile("" : "+v"(rr)); conv_rows<4>(cstate, Z, BG, BG, rr, c0, w0, w1, w2, z1, z2); }
            for (; r < r1; ++r) { int rr = r; asm volatile("" : "+v"(rr)); conv_rows<1>(cstate, Z, BG, BG, rr, c0, w0, w1, w2, z1, z2); }
        }
    }
    SEAM(3);

    if (IN(5)) { pg8::Gemm g{R1, WCO, M, D, D, 2 * D, 32}; pg8::StaticOrder S; S.init(M, D, D, G, bx, NSPLIT); pg8::EpiConvOut E{(const unsigned char*)R3, R0}; pg8::gemm_phase<true>(lds, g, S, E, PDO, (unsigned*)(ws + WS_CTL) + CW_CNT + 1 * 2048);
        { const int ntail = S.ns > 1 ? S.r * S.ns : 0;
          for (int item = vcu; item < NB * NG; item += G) { const int g = item & 63, seq = item >> 6; SsmFrags F; ssm_item_begin(a, lds, g, seq * SEQ, F, tid);
              for (int t = 0; t < 4; ++t) ssm_tile<false>(a, lds, g, seq * SEQ + t * 1024, t, t == 0, t == 3, seq, F, t < 3, tid, R2 + ((size_t)g * M + seq * SEQ + t * 1024) * 16); }
          const int nfree = G - ntail;
          for (int j = (bx >= ntail ? bx - ntail : bx + nfree); j < NG; j += G) { SsmFrags F; ssm_item_begin(a, lds, j, MP, F, tid); ssm_tile<true>(a, lds, j, MP, 0, true, true, 0, F, false, tid, R2 + ((size_t)j * M + MP) * 16); }
        }
    }
    SEAM(5);
    if (IN(6)) REP(6) { pg8::Gemm g{R2, WGLU, M, 2 * D, D, 32, 32u * M}; pg8::StaticOrder S; S.init(M, 2 * D, D, G, bx, NSPLIT); pg8::EpiGlu E{R0, (const unsigned char*)R4, R0}; pg8::gemm_phase<true>(lds, g, S, E, PDO, (unsigned*)(ws + WS_CTL) + CW_CNT + 2 * 2048); }
    SEAM(6);
    if (IN(7)) { pg8::Gemm g{R0, WOt, M, D, D, 2 * D, 32}; pg8::StaticOrder S; S.init(M, D, D, G, bx, NSPLIT); pg8::EpiResid<true, false, true> E{nullptr, nullptr, XA, nullptr, R4, ss2, 1.0f}; pg8::gemm_phase<true>(lds, g, S, E, PDO, (unsigned*)(ws + WS_CTL) + CW_CNT + 3 * 2048);
        { const int nt_ = S.ns > 1 ? S.r * S.ns : 0; if (bx >= nt_ && nt_ < G) { conv_range(a, lds, ITB_FFN2, ITB_WIN, (bx - nt_) * 8 + wave, (G - nt_) * 8, wave, lane); __syncthreads(); } } }
    SEAM(7);
    if (IN(8)) REP(8) { pg8::Gemm g{R4, WGU, M, 2 * FF, D, 2 * D, 32}; pg8::StaticOrder S; S.init(M, 2 * FF, D, G, bx, 1); pg8::EpiSwiGLU E{HB, ss2}; pg8::gemm_phase<false>(lds, g, S, E, nullptr, nullptr); }
    SEAM(8);
    const bool fuse_final = (G == 256);
    if (IN(9)) { pg8::Gemm g{HB, WDt, M, D, FF, 2 * FF, 32}; pg8::StaticOrder S;
        if (fuse_final && S.init_tailpanels(M, D, FF, G, bx, MS / 256)) {
            unsigned* fc = (unsigned*)(ws + WS_CTL) + CW_FIN;
            pg8::EpiFinal E{R4, Y, ss3, fc, fc + 64 * (M / 256), a.in[27], 0.5f}; pg8::gemm_phase<true>(lds, g, S, E, PD9, (unsigned*)(ws + WS_CTL) + CW_CNT + 4 * 2048);
        }
    }
    SEAM(9);
#undef IN
#undef SEAM
}

extern "C" void kernel_launch(void* const* d_in, const int* in_sizes, int n_in, void* d_out, int out_size, void* d_ws, size_t ws_size, hipStream_t stream) {
    static int grid = 0;
    if (grid == 0) {
        if (n_in != 28 || ws_size < WS_END) { fprintf(stderr, "kernel_launch: unexpected inputs (n_in %d, ws %zu, need %zu)\n", n_in, ws_size, (size_t)WS_END); grid = -1; return; }
        int dev = 0, cus = 0;
        if (hipGetDevice(&dev) != hipSuccess || hipDeviceGetAttribute(&cus, hipDeviceAttributeMultiprocessorCount, dev) != hipSuccess) { grid = -1; return; }
        if (hipFuncSetAttribute((const void*)mk_fwd, hipFuncAttributeMaxDynamicSharedMemorySize, LDS_BYTES) != hipSuccess) { fprintf(stderr, "kernel_launch: hipFuncSetAttribute failed\n"); grid = -1; return; }
        int per_cu = 0;
        if (hipOccupancyMaxActiveBlocksPerMultiprocessor(&per_cu, (const void*)mk_fwd, 512, LDS_BYTES) != hipSuccess || per_cu < 1) fprintf(stderr, "kernel_launch: occupancy query says %d blocks/CU\n", per_cu);
        (void)hipGetLastError();
        grid = cus > 256 ? 256 : cus;
    }
    if (grid < 0) return;
    (void)hipMemsetAsync((char*)d_ws + WS_CTL, 0, CTL_ZERO_BYTES, stream);
    Args a{};
    for (int i = 0; i < 28; ++i) a.in[i] = (const float*)d_in[i];
    a.out = (float*)d_out; a.ws = (unsigned char*)d_ws;
#if MK_N_LAUNCHES == 1
    a.ph_lo = 0; a.ph_hi = NPHASE;
    hipLaunchKernelGGL(mk_fwd, dim3(grid), dim3(512), LDS_BYTES, stream, a);
#else
    for (int p = 0; p < NPHASE; ++p) { a.ph_lo = p; a.ph_hi = p + 1; hipLaunchKernelGGL(mk_fwd, dim3(grid), dim3(512), LDS_BYTES, stream, a); }
#endif
}
```

```cpp
#include <hip/hip_runtime.h>
#include <cstdio>
#include <cstdint>

#ifndef NSPLIT
#define NSPLIT 8
#endif
#ifndef PG8_SP2
#define PG8_SP2 1
#endif
#ifndef DUP_CONV
#define DUP_CONV 0
#endif
#ifndef MK_N_LAUNCHES
#define MK_N_LAUNCHES 1
#endif

constexpr int MP = 16384, MS = 1024, M = MP + MS;
constexpr int D = 1024, FF = 2816, NIN = 6144, NG = 64, NP = 64;
constexpr int SEQ = 4096, DSEQ = 32, NB = 4, NDB = 32;
constexpr float RMS_EPS = 1e-6f;
constexpr size_t O_Y = 0, O_CONVP = (size_t)M * D, O_SREP = O_CONVP + 8192, O_SIMP = O_SREP + 16384, O_CONVS = O_SIMP + 16384, O_SRES = O_CONVS + 65536, O_SIMS = O_SRES + 131072;

#define GAS __attribute__((address_space(1)))
#define LAS __attribute__((address_space(3)))
typedef unsigned short bf16_t;
typedef short bf16x8 __attribute__((ext_vector_type(8)));
typedef float f32x4 __attribute__((ext_vector_type(4)));
typedef float f32x2 __attribute__((ext_vector_type(2)));
typedef unsigned u32x4 __attribute__((ext_vector_type(4)));
typedef unsigned u32x2 __attribute__((ext_vector_type(2)));

__device__ __forceinline__ unsigned cvt_pk_bf16(float lo, float hi) { unsigned r; asm volatile("v_cvt_pk_bf16_f32 %0, %1, %2" : "=v"(r) : "v"(lo), "v"(hi)); return r; }
__device__ __forceinline__ float bf_lo(unsigned w) { return __uint_as_float(w << 16); }
__device__ __forceinline__ float bf_hi(unsigned w) { return __uint_as_float(w & 0xffff0000u); }
__device__ __forceinline__ float sigmoid_f(float v) { return __builtin_amdgcn_rcpf(1.0f + __builtin_amdgcn_exp2f(-1.4426950409f * v)); }
__device__ __forceinline__ float silu_f(float v) { return v * sigmoid_f(v); }
__device__ __forceinline__ float gelu_tanh_f(float v) { return v * sigmoid_f(1.5957691216f * (v + 0.044715f * v * v * v)); }

__device__ __forceinline__ void st16_wt(void* p, u32x4 v) { asm volatile("global_store_dwordx4 %0, %1, off sc1\n\ts_nop 1" :: "v"(p), "v"(v) : "memory"); }
#ifdef WT_STORES
__device__ __forceinline__ void st16(void* p, u32x4 v) { asm volatile("global_store_dwordx4 %0, %1, off sc1\n\ts_nop 1" :: "v"(p), "v"(v) : "memory"); }
__device__ __forceinline__ void st8(void* p, u32x2 v) { asm volatile("global_store_dwordx2 %0, %1, off sc1\n\ts_nop 1" :: "v"(p), "v"(v) : "memory"); }
#else
__device__ __forceinline__ void st16(void* p, u32x4 v) { *(u32x4*)p = v; }
__device__ __forceinline__ void st8(void* p, u32x2 v) { *(u32x2*)p = v; }
#endif

__device__ __forceinline__ u32x2 pack_unorm8(const float (&o)[8]) {
    u32x2 w = {0u, 0u};
#pragma unroll
    for (int j = 0; j < 4; ++j) { w.x = __builtin_amdgcn_cvt_pk_u8_f32(fmaf(o[j], 255.0f, 0.5f), j, w.x); w.y = __builtin_amdgcn_cvt_pk_u8_f32(fmaf(o[4 + j], 255.0f, 0.5f), j, w.y); }
    return w;
}
__device__ __forceinline__ float unorm8(unsigned w, int j) { return (float)((w >> (8 * j)) & 0xffu) * (1.0f / 255.0f); }

constexpr int RING_BYTES = 131072;
constexpr int SCR_OFF = RING_BYTES;
constexpr int LDS_BYTES = 163840;
constexpr int LDSCTL_OFF = LDS_BYTES - 512;

namespace pg8 {
constexpr int BM = 256, BK = 64, HALF = 128, HTB = HALF * BK * 2, NXCD = 8, WGM = 8;
__host__ __device__ __forceinline__ int lds_byte(int r, int c) { const int st = (r >> 4) * 2 + (c >> 5), rr = r & 15, cc = c & 31, ob = rr * 64 + cc * 2; return st * 1024 + (ob ^ (((ob >> 9) & 1) << 5)); }
__host__ __device__ __forceinline__ void stage_rc(int b, int& R, int& C) { const int st = b / 1024, sb = b % 1024, swz = sb ^ (((sb >> 9) & 1) << 5); R = (st >> 1) * 16 + swz / 64; C = (st & 1) * 32 + (swz % 64) / 2; }
__host__ __device__ __forceinline__ int perm32(int rho) { const int n = rho >> 4, i = rho & 15; return 8 * (i >> 2) + 4 * n + (i & 3); }

struct Unit { int pm, pn, kt0, nkt, part, tidx; };
struct Gemm { const bf16_t* A; const bf16_t* Bt; int M, N, K; unsigned a_rs, a_gs; };

struct StaticOrder {
    int nM, nN, nwg, G, c, nkt, ns, q, r, mp;
    __host__ __device__ __forceinline__ void init(int M_, int N_, int K_, int G_, int c_, int ns_) { nM = M_ / BM; nN = N_ / BM; nwg = nM * nN; G = G_; c = c_; nkt = K_ / BK; ns = ns_; q = nwg / G; r = nwg - q * G; mp = nM; if (ns != 8 || r == 0 || r * ns > G || nkt < 16) ns = 1; }
    __host__ __device__ __forceinline__ bool init_tailpanels(int M_, int N_, int K_, int G_, int c_, int tp) { nM = M_ / BM; nN = N_ / BM; nwg = nM * nN; G = G_; c = c_; nkt = K_ / BK; ns = 8; mp = nM - tp;
        q = (mp * nN) / G; r = tp * nN; return (mp * nN == q * G) && (r * ns <= G) && nkt >= 16; }
    __host__ __device__ __forceinline__ void tile(int L, Unit& u) const {
        const int nm = mp, nw = mp * nN;
        if (L >= nw) { const int j = L - nw; u.pm = mp + j / nN; u.pn = j % nN; return; }
        int wgid = L; { const int qq = nw / NXCD, rr = nw % NXCD, xcd = wgid % NXCD, off = wgid / NXCD; wgid = (xcd < rr ? xcd * (qq + 1) : rr * (qq + 1) + (xcd - rr) * qq) + off; }
        const int nig = WGM * nN, gid = wgid / nig, fm = gid * WGM, gsz = (nm - fm) < WGM ? (nm - fm) : WGM;
        u.pm = fm + ((wgid % nig) % gsz); u.pn = (wgid % nig) / gsz;
    }
    __device__ __forceinline__ void after_unit(int, int) const {}
    __host__ __device__ __forceinline__ bool next(int i, Unit& u) const {
        u.kt0 = 0; u.nkt = nkt; u.part = -1; u.tidx = 0;
        if (ns > 1) {
            const bool has_tail = c < r * ns;
            if (has_tail && i == 0) { u.tidx = c / ns; u.part = c % ns; tile(q * G + u.tidx, u);
                const int pairs = nkt / 2, p0 = u.part * pairs / ns, p1 = (u.part + 1) * pairs / ns; u.kt0 = 2 * p0; u.nkt = 2 * (p1 - p0); return true; }
            const int j = has_tail ? i - 1 : i; if (j >= q) return false;
            tile(j * G + c, u); return true; }
        const long L = (long)i * G + c; if (L >= nwg) return false;
        tile((int)L, u); return true;
    }
};

constexpr int ZF_N1 = 12;
struct ZFirstOrder {
    StaticOrder A, B; int nA, nB, G, c, nkt, last_a; unsigned* done;
    __device__ __forceinline__ void init(int G_, int c_, unsigned* done_) { G = G_; c = c_; done = done_; A.init(M, ZF_N1 * BM, D, G_, c_, 1); B.init(M, (NIN / BM - ZF_N1) * BM, D, G_, c_, 1); nA = A.nwg; nB = B.nwg; nkt = D / BK;
        last_a = (c < nA) ? (nA - 1 - c) / G : -1; }
    __device__ __forceinline__ bool next(int i, Unit& u) const {
        u.kt0 = 0; u.nkt = nkt; u.part = -1; u.tidx = 0; const int L = i * G + c;
        if (L < nA) { A.tile(L, u); return true; }
        if (L < nA + nB) { B.tile(L - nA, u); u.pn += ZF_N1; return true; }
        return false;
    }
    __device__ __forceinline__ void after_unit(int ui, int tid) const {
        if (ui != last_a) return;
        asm volatile("s_waitcnt vmcnt(0)" ::: "memory"); __syncthreads();
        if (tid == 0) { __builtin_amdgcn_fence(__ATOMIC_RELEASE, "agent"); asm volatile("s_waitcnt vmcnt(0)" ::: "memory"); __hip_atomic_fetch_add(done, 1u, __ATOMIC_RELAXED, __HIP_MEMORY_SCOPE_AGENT); }
    }
    __device__ __forceinline__ int publishers() const { return nA < G ? nA : G; }
    __device__ __forceinline__ bool has_last_round_unit() const { return ((nA + nB - 1) / G) * G + c < nA + nB; }
};

typedef f32x4 Acc[2][2][4][2];

__device__ __forceinline__ float rrms_of(const float* ss, int row) { const f32x4 p = *(const f32x4*)(ss + (size_t)row * 4); return rsqrtf(((p[0] + p[1]) + (p[2] + p[3])) * (1.0f / D) + RMS_EPS); }

typedef f32x4 Slice[2][2];
struct EpiSwiGLU {
    static constexpr bool PERM = true, IDEM = true, RSCALE = true, FINAL = false; static constexpr int BATCH = 1;
    bf16_t* H; const float* ss;
    struct In {};
    __device__ __forceinline__ In load(const Unit&, int, int, int, int, int, int) const { return In{}; }
    __device__ __forceinline__ void rows(const Slice& v, const In&, const Unit& u, int ai, int m, int wr, int wc, int fr, int fq, LAS float* scr) const {
        const int rt = ai * HALF + wr * 64 + m * 16 + fr, row = u.pm * BM + rt, col0 = u.pn * HALF + wc * 32 + 8 * fq; const float s = scr[rt], s2 = s * s, sl = -1.4426950409f * s;
        float o[8];
#pragma unroll
        for (int n = 0; n < 2; ++n)
#pragma unroll
            for (int j = 0; j < 4; ++j) { const float gg = v[0][n][j]; o[n * 4 + j] = (gg * v[1][n][j]) * (s2 * __builtin_amdgcn_rcpf(1.0f + __builtin_amdgcn_exp2f(gg * sl))); }
        u32x4 w; w.x = cvt_pk_bf16(o[0], o[1]); w.y = cvt_pk_bf16(o[2], o[3]); w.z = cvt_pk_bf16(o[4], o[5]); w.w = cvt_pk_bf16(o[6], o[7]);
        st16(H + (size_t)row * FF + col0, w);
    }
    __device__ __forceinline__ void finish(const Unit&, LAS unsigned char*, int, int) const {}
};

template <bool BASE_BF16, bool OUT_F32, bool OUT_BF16>
struct EpiResid {
    static constexpr bool PERM = true, IDEM = true, RSCALE = false, FINAL = false; static constexpr int BATCH = 4;
    const float* base_p; const float* base_s; const bf16_t* base_b; float* out; bf16_t* xb; float* ss; float alpha;
    struct In { f32x4 b[2][2]; u32x4 w[2]; };
    __device__ __forceinline__ In load(const Unit& u, int ai, int m, int wr, int wc, int fr, int fq) const {
        const int row = u.pm * BM + ai * HALF + wr * 64 + m * 16 + fr, col0 = u.pn * BM + wc * 32 + 8 * fq; const size_t off = (size_t)row * D + col0;
        const float* base = (u.pm < MP / BM) ? base_p : (base_s - (size_t)MP * D); In in;
#pragma unroll
        for (int bj = 0; bj < 2; ++bj) {
            if (BASE_BF16) in.w[bj] = *(const u32x4*)(base_b + off + bj * HALF);
            else { in.b[bj][0] = *(const f32x4*)(base + off + bj * HALF); in.b[bj][1] = *(const f32x4*)(base + off + bj * HALF + 4); } }
        return in;
    }
    __device__ __forceinline__ void rows(const Slice& v, const In& in, const Unit& u, int ai, int m, int wr, int wc, int fr, int fq, LAS float* scr) const {
        const int rt = ai * HALF + wr * 64 + m * 16 + fr, row = u.pm * BM + rt, col0 = u.pn * BM + wc * 32 + 8 * fq;
        const size_t off = (size_t)row * D + col0; float sq = 0.f;
#pragma unroll
        for (int bj = 0; bj < 2; ++bj) { f32x4 b0, b1;
            if (BASE_BF16) { const u32x4 w = in.w[bj]; b0 = (f32x4){bf_lo(w.x), bf_hi(w.x), bf_lo(w.y), bf_hi(w.y)}; b1 = (f32x4){bf_lo(w.z), bf_hi(w.z), bf_lo(w.w), bf_hi(w.w)}; } else { b0 = in.b[bj][0]; b1 = in.b[bj][1]; }
            const f32x4 x0 = b0 + alpha * v[bj][0], x1 = b1 + alpha * v[bj][1];
            if (OUT_F32) { *(f32x4*)(out + off + bj * HALF) = x0; *(f32x4*)(out + off + bj * HALF + 4) = x1; }
            sq += ((x0[0] * x0[0] + x0[1] * x0[1]) + (x0[2] * x0[2] + x0[3] * x0[3])) + ((x1[0] * x1[0] + x1[1] * x1[1]) + (x1[2] * x1[2] + x1[3] * x1[3]));
            if (OUT_BF16) { u32x4 w; w.x = cvt_pk_bf16(x0[0], x0[1]); w.y = cvt_pk_bf16(x0[2], x0[3]); w.z = cvt_pk_bf16(x1[0], x1[1]); w.w = cvt_pk_bf16(x1[2], x1[3]); st16(xb + off + bj * HALF, w); } }
        sq += __shfl_xor(sq, 16); sq += __shfl_xor(sq, 32);
        if (fq == 0) scr[rt * 4 + wc] = sq;
    }
    __device__ __forceinline__ void finish(const Unit& u, LAS unsigned char* lds, int tid, int sel) const {
        LAS float* scr = (LAS float*)(lds + SCR_OFF);
        asm volatile("s_waitcnt lgkmcnt(0)" ::: "memory"); __builtin_amdgcn_s_barrier(); asm volatile("" ::: "memory");
        if (tid < 256 && (sel < 0 || (((tid >> 7) * 4 + ((tid >> 4) & 3)) == sel))) { const f32x4 p = *(const LAS f32x4*)(scr + tid * 4); ss[(size_t)(u.pm * BM + tid) * 4 + u.pn] = (p[0] + p[1]) + (p[2] + p[3]); }
    }
};

struct EpiMixIn {
    static constexpr bool PERM = true, IDEM = true, RSCALE = true, FINAL = false; static constexpr int BATCH = 1;
    bf16_t *Z, *BG, *U; unsigned char *SG8C, *SG8S; const float* ss; float* dout;
    struct In {};
    __device__ __forceinline__ In load(const Unit&, int, int, int, int, int, int) const { return In{}; }
    __device__ __forceinline__ void rows(const Slice& v, const In&, const Unit& u, int ai, int m, int wr, int wc, int fr, int fq, LAS float* scr) const {
        const int rt = ai * HALF + wr * 64 + m * 16 + fr, row = u.pm * BM + rt; const int pn = u.pn; const float s = scr[rt];
        if (pn < 8) {
            const int col = pn * HALF + wc * 32 + 8 * fq; float o[8];
#pragma unroll
            for (int n = 0; n < 2; ++n)
#pragma unroll
                for (int j = 0; j < 4; ++j) o[n * 4 + j] = (s * v[0][n][j]) * (s * v[1][n][j]);
            u32x4 w; w.x = cvt_pk_bf16(o[0], o[1]); w.y = cvt_pk_bf16(o[2], o[3]); w.z = cvt_pk_bf16(o[4], o[5]); w.w = cvt_pk_bf16(o[6], o[7]);
            st16(Z + (size_t)row * D + col, w);
            int t, seq; float* cs;
            if (row < MP) { seq = row >> 12; t = (row & 4095) - (SEQ - 2); cs = dout + O_CONVP; } else { const int r2 = row - MP; seq = r2 >> 5; t = (r2 & 31) - (DSEQ - 2); cs = dout + O_CONVS; }
            if (t >= 0) { float* p = cs + ((size_t)seq * 2 + t) * D + col; *(f32x4*)p = (f32x4){o[0], o[1], o[2], o[3]}; *(f32x4*)(p + 4) = (f32x4){o[4], o[5], o[6], o[7]}; }
        } else {
#pragma unroll
            for (int bj = 0; bj < 2; ++bj) { const int cc = (pn & 3) * BM + bj * HALF + wc * 32 + 8 * fq; float o[8];
#pragma unroll
                for (int n = 0; n < 2; ++n)
#pragma unroll
                    for (int j = 0; j < 4; ++j) { const float x = s * v[bj][n][j]; o[n * 4 + j] = (pn >= 16) ? sigmoid_f(x) : x; }
                if (pn >= 16) { const u32x2 g8 = pack_unorm8(o); st8((pn < 20 ? SG8C : SG8S) + (size_t)row * D + cc, g8); }
                else { u32x4 w; w.x = cvt_pk_bf16(o[0], o[1]); w.y = cvt_pk_bf16(o[2], o[3]); w.z = cvt_pk_bf16(o[4], o[5]); w.w = cvt_pk_bf16(o[6], o[7]);
                    if (pn < 12) st16(BG + (size_t)row * D + cc, w);
                    else st16(U + ((size_t)(cc >> 4) * M + row) * 16 + (cc & 15), w); } }
        }
    }
    __device__ __forceinline__ void finish(const Unit&, LAS unsigned char*, int, int) const {}
};

struct EpiConvOut {
    static constexpr bool PERM = true, IDEM = true, RSCALE = false, FINAL = false; static constexpr int BATCH = 8;
    const unsigned char* G8; bf16_t* T;
    struct In { u32x2 g[2]; };
    __device__ __forceinline__ In load(const Unit& u, int ai, int m, int wr, int wc, int fr, int fq) const {
        const int row = u.pm * BM + ai * HALF + wr * 64 + m * 16 + fr, col0 = u.pn * BM + wc * 32 + 8 * fq; In in;
#pragma unroll
        for (int bj = 0; bj < 2; ++bj) in.g[bj] = *(const u32x2*)(G8 + (size_t)row * D + col0 + bj * HALF);
        return in;
    }
    __device__ __forceinline__ void rows(const Slice& v, const In& in, const Unit& u, int ai, int m, int wr, int wc, int fr, int fq, LAS float*) const {
        const int row = u.pm * BM + ai * HALF + wr * 64 + m * 16 + fr, col0 = u.pn * BM + wc * 32 + 8 * fq;
#pragma unroll
        for (int bj = 0; bj < 2; ++bj) { const u32x2 g = in.g[bj]; u32x4 w;
            w.x = cvt_pk_bf16(unorm8(g.x, 0) * v[bj][0][0], unorm8(g.x, 1) * v[bj][0][1]); w.y = cvt_pk_bf16(unorm8(g.x, 2) * v[bj][0][2], unorm8(g.x, 3) * v[bj][0][3]);
            w.z = cvt_pk_bf16(unorm8(g.y, 0) * v[bj][1][0], unorm8(g.y, 1) * v[bj][1][1]); w.w = cvt_pk_bf16(unorm8(g.y, 2) * v[bj][1][2], unorm8(g.y, 3) * v[bj][1][3]);
            st16(T + (size_t)row * D + col0 + bj * HALF, w); }
    }
    __device__ __forceinline__ void finish(const Unit&, LAS unsigned char*, int, int) const {}
};

struct EpiGlu {
    static constexpr bool PERM = true, IDEM = true, RSCALE = false, FINAL = false; static constexpr int BATCH = 8;
    const bf16_t* T0; const unsigned char* SG8; bf16_t* MG;
    struct In { u32x4 t; u32x2 g; };
    __device__ __forceinline__ In load(const Unit& u, int ai, int m, int wr, int wc, int fr, int fq) const {
        const int row = u.pm * BM + ai * HALF + wr * 64 + m * 16 + fr, col0 = u.pn * HALF + wc * 32 + 8 * fq; const size_t off = (size_t)row * D + col0;
        In in; in.t = *(const u32x4*)(T0 + off); in.g = *(const u32x2*)(SG8 + off); return in;
    }
    __device__ __forceinline__ void rows(const Slice& v, const In& in, const Unit& u, int ai, int m, int wr, int wc, int fr, int fq, LAS float*) const {
        const int row = u.pm * BM + ai * HALF + wr * 64 + m * 16 + fr, col0 = u.pn * HALF + wc * 32 + 8 * fq; const size_t off = (size_t)row * D + col0;
        const u32x4 t = in.t; const u32x2 g = in.g; float o[8];
        const float tv[8] = {bf_lo(t.x), bf_hi(t.x), bf_lo(t.y), bf_hi(t.y), bf_lo(t.z), bf_hi(t.z), bf_lo(t.w), bf_hi(t.w)};
        const float gv[8] = {unorm8(g.x, 0), unorm8(g.x, 1), unorm8(g.x, 2), unorm8(g.x, 3), unorm8(g.y, 0), unorm8(g.y, 1), unorm8(g.y, 2), unorm8(g.y, 3)};
#pragma unroll
        for (int n = 0; n < 2; ++n)
#pragma unroll
            for (int j = 0; j < 4; ++j) o[n * 4 + j] = tv[n * 4 + j] + gv[n * 4 + j] * v[0][n][j] * sigmoid_f(v[1][n][j]);
        u32x4 w; w.x = cvt_pk_bf16(o[0], o[1]); w.y = cvt_pk_bf16(o[2], o[3]); w.z = cvt_pk_bf16(o[4], o[5]); w.w = cvt_pk_bf16(o[6], o[7]);
        st16(MG + off, w);
    }
    __device__ __forceinline__ void finish(const Unit&, LAS unsigned char*, int, int) const {}
};

struct EpiFinal {
    static constexpr bool PERM = true, IDEM = false, RSCALE = false, FINAL = true;
    const bf16_t* base_b; float* Y; float* xs; unsigned* cnt; unsigned* cnt2; const float* g; float alpha;
    struct In { u32x4 w[2]; };
    struct Gv { f32x4 g[2][2]; };
    __device__ __forceinline__ In load(const Unit& u, int ai, int m, int wr, int wc, int fr, int fq) const {
        const int row = u.pm * BM + ai * HALF + wr * 64 + m * 16 + fr, col0 = u.pn * BM + wc * 32 + 8 * fq; const size_t off = (size_t)row * D + col0; In in;
#pragma unroll
        for (int bj = 0; bj < 2; ++bj) in.w[bj] = *(const u32x4*)(base_b + off + bj * HALF);
        return in;
    }
    __device__ __forceinline__ Gv load_g(const Unit& u, int wc, int fq) const { const int col0 = u.pn * BM + wc * 32 + 8 * fq; Gv r;
#pragma unroll
        for (int bj = 0; bj < 2; ++bj)
#pragma unroll
            for (int n = 0; n < 2; ++n) r.g[bj][n] = *(const f32x4*)(g + col0 + bj * HALF + n * 4);
        return r; }
    __device__ __forceinline__ void pass1(Slice& v, const In& in, const Unit& u, int ai, int m, int wr, int wc, int fr, int fq, LAS float* scr) const {
        const int rt = ai * HALF + wr * 64 + m * 16 + fr; float sq = 0.f;
#pragma unroll
        for (int bj = 0; bj < 2; ++bj) { const u32x4 w = in.w[bj];
#pragma unroll
            for (int n = 0; n < 2; ++n) { const unsigned w0 = n ? w.z : w.x, w1 = n ? w.w : w.y; const f32x4 b = {bf_lo(w0), bf_hi(w0), bf_lo(w1), bf_hi(w1)};
                const f32x4 x = b + alpha * v[bj][n]; v[bj][n] = x; sq += (x[0] * x[0] + x[1] * x[1]) + (x[2] * x[2] + x[3] * x[3]); } }
        sq += __shfl_xor(sq, 16); sq += __shfl_xor(sq, 32);
        if (fq == 0) scr[rt * 4 + wc] = sq;
    }
    __device__ __forceinline__ void exchange(const Unit& u, int sel, LAS unsigned char* lds, int tid) const {
        LAS float* scr = (LAS float*)(lds + SCR_OFF); const int wid = __builtin_amdgcn_readfirstlane(tid >> 6), lane = tid & 63;
        const bool mine = tid < 256 && (sel < 0 || (((tid >> 7) * 4 + ((tid >> 4) & 3)) == sel));
        unsigned* c = sel < 0 ? cnt + 64 * u.pm : cnt2 + 64 * ((u.pm - MP / BM) * 8 + sel);
        asm volatile("s_waitcnt lgkmcnt(0)" ::: "memory"); __builtin_amdgcn_s_barrier(); asm volatile("" ::: "memory");
        if (mine) { const f32x4 p = *(const LAS f32x4*)(scr + tid * 4); __hip_atomic_store((unsigned*)(xs + (size_t)(u.pm * BM + tid) * 4 + u.pn), __float_as_uint((p[0] + p[1]) + (p[2] + p[3])), __ATOMIC_RELAXED, __HIP_MEMORY_SCOPE_AGENT); }
        asm volatile("s_waitcnt vmcnt(0)" ::: "memory");
        if (lane == 0) __hip_atomic_fetch_add(c, 1u, __ATOMIC_RELAXED, __HIP_MEMORY_SCOPE_AGENT);
        if (wid == 0) { unsigned sp = 0; while ((unsigned)__builtin_amdgcn_readfirstlane(__hip_atomic_load(c, __ATOMIC_RELAXED, __HIP_MEMORY_SCOPE_AGENT)) < 32u) { __builtin_amdgcn_s_sleep(2); if (++sp > (1u << 22)) break; }
            __builtin_amdgcn_fence(__ATOMIC_ACQUIRE, "agent"); }
        asm volatile("s_waitcnt vmcnt(0) lgkmcnt(0)" ::: "memory"); __builtin_amdgcn_s_barrier(); asm volatile("" ::: "memory");
        if (mine) { const unsigned* sl = (const unsigned*)(xs + (size_t)(u.pm * BM + tid) * 4); float t = 0.f;
#pragma unroll
            for (int k = 0; k < 4; ++k) t += __uint_as_float(__hip_atomic_load(sl + k, __ATOMIC_RELAXED, __HIP_MEMORY_SCOPE_AGENT));
            scr[1024 + tid] = rsqrtf(t * (1.0f / D) + RMS_EPS); }
        asm volatile("s_waitcnt lgkmcnt(0)" ::: "memory"); __builtin_amdgcn_s_barrier(); asm volatile("" ::: "memory");
    }
    __device__ __forceinline__ void pass2(const Slice& v, const Gv& gv, const Unit& u, int ai, int m, int wr, int wc, int fr, int fq, const LAS float* scr) const {
        const int rt = ai * HALF + wr * 64 + m * 16 + fr, row = u.pm * BM + rt, col0 = u.pn * BM + wc * 32 + 8 * fq; const size_t off = (size_t)row * D + col0; const float s = scr[1024 + rt];
#pragma unroll
        for (int bj = 0; bj < 2; ++bj)
#pragma unroll
            for (int n = 0; n < 2; ++n) *(f32x4*)(Y + off + bj * HALF + n * 4) = v[bj][n] * s * gv.g[bj][n];
    }
};

template <class Epi>
__device__ __forceinline__ void run_epilogue(const Epi& E, const Acc& acc, const Unit& u, int wr, int wc, int fr, int fq, LAS unsigned char* lds, int tid, int par, bool has_next, int next_pm) {
    LAS float* scr = (LAS float*)(lds + SCR_OFF);
    LAS float* tab = scr + 1024 + par * 256;
    f32x4 nx = {1.f, 1.f, 1.f, 1.f};
    if constexpr (Epi::RSCALE) { if (has_next) nx = *(const f32x4*)(E.ss + (size_t)(next_pm * BM + (tid & 255)) * 4); }
    constexpr int NB = Epi::BATCH;
#pragma unroll
    for (int k0 = 0; k0 < 8; k0 += NB) { typename Epi::In in[NB];
#pragma unroll
        for (int k = 0; k < NB; ++k) in[k] = E.load(u, (k0 + k) >> 2, (k0 + k) & 3, wr, wc, fr, fq);
#pragma unroll
        for (int k = 0; k < NB; ++k) { const int ai = (k0 + k) >> 2, m = (k0 + k) & 3;
            const Slice v = {{acc[ai][0][m][0], acc[ai][0][m][1]}, {acc[ai][1][m][0], acc[ai][1][m][1]}}; E.rows(v, in[k], u, ai, m, wr, wc, fr, fq, Epi::RSCALE ? tab : scr); } }
    if (Epi::RSCALE && has_next) scr[1024 + (par ^ 1) * 256 + (tid & 255)] = rsqrtf(((nx[0] + nx[1]) + (nx[2] + nx[3])) * (1.0f / D) + RMS_EPS);
    E.finish(u, lds, tid, -1);
}
__device__ __forceinline__ void store_partial(u32x2* P, int ns, const Acc& acc, const Unit& u, int tid) {
    u32x2* p = P + ((size_t)(u.tidx * ns + u.part) * 32) * 512 + tid;
#pragma unroll
    for (int ai = 0; ai < 2; ++ai)
#pragma unroll
        for (int bj = 0; bj < 2; ++bj)
#pragma unroll
            for (int m = 0; m < 4; ++m)
#pragma unroll
                for (int n = 0; n < 2; ++n) { const f32x4 v = acc[ai][bj][m][n]; u32x2 w; w.x = cvt_pk_bf16(v[0], v[1]); w.y = cvt_pk_bf16(v[2], v[3]);
                    asm volatile("global_store_dwordx2 %0, %1, off sc1\n\ts_nop 1" :: "v"(&p[(size_t)((((ai * 2 + bj) * 4 + m) * 2 + n)) * 512]), "v"(w) : "memory"); }
}
template <bool SPLIT, class Epi, class Ord>
__device__ __forceinline__ void gemm_phase(LAS unsigned char* lds, const Gemm g, const Ord& S, const Epi& E, u32x2* P, unsigned* cnt) {
    const int tid = threadIdx.x, wid = __builtin_amdgcn_readfirstlane(tid >> 6), lane = tid & 63, wr = wid >> 2, wc = wid & 3, fr = lane & 15, fq = lane >> 4;
    const int K = g.K;
    unsigned voffA[2], voffB[2];
#pragma unroll
    for (int i = 0; i < 2; ++i) { int R, C; stage_rc(tid * 16 + i * 8192, R, C); const int Rb = Epi::PERM ? ((R & ~31) + perm32(R & 31)) : R;
        voffA[i] = (unsigned)R * g.a_rs + (unsigned)(C >> 4) * g.a_gs + (unsigned)(C & 15) * 2u; voffB[i] = (unsigned)(Rb * K + C) * 2u; }
    const size_t kstepA = (size_t)4 * g.a_gs, hstepA = (size_t)HALF * g.a_rs, tstepA = 2 * hstepA;
    const size_t kstepB = (size_t)(BK * 2), hstepB = (size_t)HALF * K * 2, tstepB = 2 * hstepB;
    const unsigned ldsw = (unsigned)wid * 1024u;
    const int aoff = lds_byte(wr * 64 + fr, fq * 8), boff = lds_byte(wc * 32 + fr, fq * 8);
#define PG8_SA(b, h) (((b) * 2 + (h)) * HTB)
#define PG8_SB(b, h) ((4 + (b) * 2 + (h)) * HTB)
#define PG8_STAGE(bufoff, gbase, voff) do { _Pragma("unroll") for (int _i = 0; _i < 2; ++_i) \
        __builtin_amdgcn_global_load_lds((const unsigned*)((const char*)(gbase) + (voff)[_i]), (LAS unsigned*)(lds + (bufoff) + ldsw + _i * 8192), 16, 0, 0); } while (0)
#define PG8_LDA(dst, b, h) do { _Pragma("unroll") for (int m = 0; m < 4; ++m) _Pragma("unroll") for (int k = 0; k < 2; ++k) dst[m][k] = *(const LAS bf16x8*)(lds + PG8_SA(b, h) + aoff + m * 2048 + k * 1024); } while (0)
#define PG8_LDB(dst, b, h) do { _Pragma("unroll") for (int n = 0; n < 2; ++n) _Pragma("unroll") for (int k = 0; k < 2; ++k) dst[n][k] = *(const LAS bf16x8*)(lds + PG8_SB(b, h) + boff + n * 2048 + k * 1024); } while (0)
#define PG8_MMA(ai, bj, At, Bt) do { __builtin_amdgcn_s_setprio(1); _Pragma("unroll") for (int m = 0; m < 4; ++m) _Pragma("unroll") for (int n = 0; n < 2; ++n) _Pragma("unroll") for (int k = 0; k < 2; ++k) \
        acc[ai][bj][m][n] = __builtin_amdgcn_mfma_f32_16x16x32_bf16(Bt[n][k], At[m][k], acc[ai][bj][m][n], 0, 0, 0); __builtin_amdgcn_s_setprio(0); } while (0)
#define PG8_WAIT_V(n) asm volatile("s_waitcnt vmcnt(" #n ")" ::: "memory")
#define PG8_WAIT_L(n) asm volatile("s_waitcnt lgkmcnt(" #n ")" ::: "memory")
#define PG8_BAR __builtin_amdgcn_s_barrier()
#define PG8_SCHED __builtin_amdgcn_sched_barrier(0)
    Unit cur, nxt; int ui = 0;
    if (!S.next(0, cur)) return;
    Acc acc;
#pragma unroll
    for (int a = 0; a < 2; ++a)
#pragma unroll
        for (int b = 0; b < 2; ++b)
#pragma unroll
            for (int m = 0; m < 4; ++m)
#pragma unroll
                for (int n = 0; n < 2; ++n) acc[a][b][m][n] = (f32x4){0.f, 0.f, 0.f, 0.f};
    bf16x8 At[4][2], B0[2][2], B1[2][2];
    if constexpr (Epi::RSCALE) { if (tid < 256) ((LAS float*)(lds + SCR_OFF))[1024 + tid] = rrms_of(E.ss, cur.pm * BM + tid); }
    const char* cA = (const char*)g.A + (size_t)cur.pm * tstepA + (size_t)cur.kt0 * kstepA; const char* cB = (const char*)g.Bt + (size_t)cur.pn * tstepB + (size_t)cur.kt0 * kstepB;
#if PG8_SP2
    PG8_STAGE(PG8_SB(0, 0), cB, voffB); PG8_STAGE(PG8_SB(0, 1), cB + hstepB, voffB); PG8_STAGE(PG8_SA(0, 0), cA, voffA); PG8_STAGE(PG8_SA(0, 1), cA + hstepA, voffA);
    if (wr == 1) PG8_BAR;
    PG8_WAIT_V(2); PG8_BAR;
    PG8_STAGE(PG8_SB(1, 0), cB + kstepB, voffB); PG8_STAGE(PG8_SA(1, 0), cA + kstepA, voffA); PG8_STAGE(PG8_SB(1, 1), cB + hstepB + kstepB, voffB);
    PG8_WAIT_V(6); PG8_BAR;
#else
    PG8_STAGE(PG8_SB(0, 0), cB, voffB); PG8_STAGE(PG8_SA(0, 0), cA, voffA); PG8_STAGE(PG8_SB(0, 1), cB + hstepB, voffB); PG8_STAGE(PG8_SA(0, 1), cA + hstepA, voffA);
    if (wr == 1) PG8_BAR;
    PG8_WAIT_V(4); PG8_BAR;
    PG8_STAGE(PG8_SB(1, 0), cB + kstepB, voffB); PG8_STAGE(PG8_SA(1, 0), cA + kstepA, voffA); PG8_STAGE(PG8_SB(1, 1), cB + hstepB + kstepB, voffB);
    PG8_WAIT_V(6); PG8_BAR;
#endif
    for (;;) {
#ifdef KDUP
        const bool has_next = S.next((ui + 1) >> 1, nxt); const bool do_epi = (ui & 1) != 0;
#else
        const bool has_next = S.next(ui + 1, nxt); const bool do_epi = true;
#endif
        const char* nA = has_next ? (const char*)g.A + (size_t)nxt.pm * tstepA + (size_t)nxt.kt0 * kstepA : cA; const char* nB = has_next ? (const char*)g.Bt + (size_t)nxt.pn * tstepB + (size_t)nxt.kt0 * kstepB : cB;
        const int nt = cur.nkt;
        for (int t = 0; t < nt; t += 2) {
            const bool last = (t == nt - 2);
            const char* a1 = cA + (size_t)(t + 1) * kstepA;
            const char* a2 = last ? nA : cA + (size_t)(t + 2) * kstepA; const char* b2 = last ? nB : cB + (size_t)(t + 2) * kstepB;
            const char* a3 = a2 + kstepA; const char* b3 = b2 + kstepB;
#if PG8_SP2
            PG8_LDB(B0, 0, 0); PG8_LDB(B1, 0, 1); PG8_SCHED; PG8_LDA(At, 0, 0); PG8_STAGE(PG8_SA(1, 1), a1 + hstepA, voffA);
            PG8_WAIT_V(8); PG8_WAIT_L(0); PG8_BAR; PG8_MMA(0, 0, At, B0); PG8_MMA(0, 1, At, B1); PG8_BAR; PG8_SCHED;
            PG8_LDA(At, 0, 1); PG8_STAGE(PG8_SB(0, 0), b2, voffB); PG8_STAGE(PG8_SB(0, 1), b2 + hstepB, voffB); PG8_STAGE(PG8_SA(0, 0), a2, voffA);
            PG8_WAIT_V(8); PG8_WAIT_L(0); PG8_BAR; PG8_MMA(1, 0, At, B0); PG8_MMA(1, 1, At, B1); PG8_BAR; PG8_SCHED;
            PG8_LDB(B0, 1, 0); PG8_LDB(B1, 1, 1); PG8_SCHED; PG8_LDA(At, 1, 0); PG8_STAGE(PG8_SA(0, 1), a2 + hstepA, voffA);
            PG8_WAIT_V(8); PG8_WAIT_L(0); PG8_BAR; PG8_MMA(0, 0, At, B0); PG8_MMA(0, 1, At, B1); PG8_BAR; PG8_SCHED;
            PG8_LDA(At, 1, 1); PG8_STAGE(PG8_SB(1, 0), b3, voffB); PG8_STAGE(PG8_SB(1, 1), b3 + hstepB, voffB); PG8_STAGE(PG8_SA(1, 0), a3, voffA);
            PG8_WAIT_V(8); PG8_WAIT_L(0); PG8_BAR; PG8_MMA(1, 0, At, B0); PG8_MMA(1, 1, At, B1); PG8_BAR; PG8_SCHED;
#else
            PG8_LDB(B0, 0, 0); PG8_SCHED; PG8_LDA(At, 0, 0); PG8_STAGE(PG8_SA(1, 1), a1 + hstepA, voffA);
            PG8_WAIT_L(8); PG8_BAR; PG8_WAIT_L(0); PG8_MMA(0, 0, At, B0); PG8_BAR; PG8_SCHED;
            PG8_LDB(B1, 0, 1); PG8_STAGE(PG8_SB(0, 0), b2, voffB);
            PG8_BAR; PG8_WAIT_L(0); PG8_MMA(0, 1, At, B1); PG8_BAR;
            PG8_LDA(At, 0, 1); PG8_STAGE(PG8_SA(0, 0), a2, voffA);
            PG8_BAR; PG8_WAIT_L(0); PG8_MMA(1, 0, At, B0); PG8_BAR; PG8_SCHED;
            PG8_STAGE(PG8_SB(0, 1), b2 + hstepB, voffB);
            PG8_WAIT_V(6); PG8_BAR; PG8_MMA(1, 1, At, B1); PG8_BAR;
            PG8_LDB(B0, 1, 0); PG8_SCHED; PG8_LDA(At, 1, 0); PG8_STAGE(PG8_SA(0, 1), a2 + hstepA, voffA);
            PG8_WAIT_L(8); PG8_BAR; PG8_WAIT_L(0); PG8_MMA(0, 0, At, B0); PG8_BAR; PG8_SCHED;
            PG8_LDB(B1, 1, 1); PG8_STAGE(PG8_SB(1, 0), b3, voffB);
            PG8_BAR; PG8_WAIT_L(0); PG8_MMA(0, 1, At, B1); PG8_BAR;
            PG8_LDA(At, 1, 1); PG8_STAGE(PG8_SA(1, 0), a3, voffA);
            PG8_BAR; PG8_WAIT_L(0); PG8_MMA(1, 0, At, B0); PG8_BAR; PG8_SCHED;
            PG8_STAGE(PG8_SB(1, 1), b3 + hstepB, voffB);
            PG8_WAIT_V(6); PG8_BAR; PG8_MMA(1, 1, At, B1); PG8_BAR;
#endif
        }
        if (wr == 0) PG8_BAR;
#ifdef KDUP
        if (do_epi) { _Pragma("unroll") for (int a_ = 0; a_ < 2; ++a_) _Pragma("unroll") for (int b_ = 0; b_ < 2; ++b_) _Pragma("unroll") for (int m_ = 0; m_ < 4; ++m_) _Pragma("unroll") for (int n_ = 0; n_ < 2; ++n_) acc[a_][b_][m_][n_] *= 0.5f; }
#endif
        if (!do_epi) {}
#ifdef EDUP
        else if (!SPLIT || cur.part < 0) { static_assert(!Epi::FINAL, "EDUP probe predates the fused final epilogue"); run_epilogue(E, acc, cur, wr, wc, fr, fq, lds, tid, ui & 1, false, 0); if (Epi::IDEM) { asm volatile("" ::: "memory"); run_epilogue(E, acc, cur, wr, wc, fr, fq, lds, tid, ui & 1, has_next, nxt.pm); } }
#else
        else if (!SPLIT || cur.part < 0) {
            if constexpr (Epi::FINAL) { LAS float* scr = (LAS float*)(lds + SCR_OFF);
                { typename Epi::In in[8];
#pragma unroll
                  for (int k = 0; k < 8; ++k) in[k] = E.load(cur, k >> 2, k & 3, wr, wc, fr, fq);
#pragma unroll
                  for (int k = 0; k < 8; ++k) { const int ai = k >> 2, m = k & 3; Slice v = {{acc[ai][0][m][0], acc[ai][0][m][1]}, {acc[ai][1][m][0], acc[ai][1][m][1]}}; E.pass1(v, in[k], cur, ai, m, wr, wc, fr, fq, scr);
                      acc[ai][0][m][0] = v[0][0]; acc[ai][0][m][1] = v[0][1]; acc[ai][1][m][0] = v[1][0]; acc[ai][1][m][1] = v[1][1]; } }
                const typename Epi::Gv gv = E.load_g(cur, wc, fq);
                E.exchange(cur, -1, lds, tid);
#pragma unroll
                for (int ai = 0; ai < 2; ++ai)
#pragma unroll
                    for (int m = 0; m < 4; ++m) { const Slice v = {{acc[ai][0][m][0], acc[ai][0][m][1]}, {acc[ai][1][m][0], acc[ai][1][m][1]}}; E.pass2(v, gv, cur, ai, m, wr, wc, fr, fq, scr); }
            } else run_epilogue(E, acc, cur, wr, wc, fr, fq, lds, tid, ui & 1, has_next, nxt.pm);
            S.after_unit(ui, tid);
        }
#endif
        else {
            store_partial(P, 8, acc, cur, tid);
            asm volatile("s_waitcnt vmcnt(0)" ::: "memory"); __syncthreads();
            if (tid == 0) { unsigned* c = cnt + 64 * cur.tidx;
                __hip_atomic_fetch_add(c, 1u, __ATOMIC_RELAXED, __HIP_MEMORY_SCOPE_AGENT);
                unsigned sp = 0; while (__hip_atomic_load(c, __ATOMIC_RELAXED, __HIP_MEMORY_SCOPE_AGENT) < 8u) { __builtin_amdgcn_s_sleep(1); if (++sp > (1u << 22)) break; } }
            __syncthreads();
            const int sel = cur.part, sai = sel >> 2, sm = sel & 3; LAS float* scr = (LAS float*)(lds + SCR_OFF);
            Slice v = {{{0.f, 0.f, 0.f, 0.f}, {0.f, 0.f, 0.f, 0.f}}, {{0.f, 0.f, 0.f, 0.f}, {0.f, 0.f, 0.f, 0.f}}};
            { u32x2 t[8][2][2];
#pragma unroll
              for (int pp = 0; pp < 8; ++pp) { const u32x2* p = P + ((size_t)(cur.tidx * 8 + pp) * 32) * 512 + tid;
#pragma unroll
                  for (int bj = 0; bj < 2; ++bj)
#pragma unroll
                      for (int n = 0; n < 2; ++n) { const unsigned long long q8 = __hip_atomic_load((const unsigned long long*)&p[(size_t)((((sai * 2 + bj) * 4 + sm) * 2 + n)) * 512], __ATOMIC_RELAXED, __HIP_MEMORY_SCOPE_AGENT);
                          t[pp][bj][n] = (u32x2){(unsigned)q8, (unsigned)(q8 >> 32)}; } }
#pragma unroll
              for (int pp = 0; pp < 8; ++pp)
#pragma unroll
                  for (int bj = 0; bj < 2; ++bj)
#pragma unroll
                      for (int n = 0; n < 2; ++n) { const u32x2 w = t[pp][bj][n]; v[bj][n] += (f32x4){bf_lo(w.x), bf_hi(w.x), bf_lo(w.y), bf_hi(w.y)}; } }
            Unit fu = cur; fu.part = -1;
            if constexpr (Epi::FINAL) { const typename Epi::In fin = E.load(fu, sai, sm, wr, wc, fr, fq); const typename Epi::Gv gv = E.load_g(fu, wc, fq); E.pass1(v, fin, fu, sai, sm, wr, wc, fr, fq, scr); E.exchange(fu, sel, lds, tid); E.pass2(v, gv, fu, sai, sm, wr, wc, fr, fq, scr); }
            else { const typename Epi::In fin = E.load(fu, sai, sm, wr, wc, fr, fq); E.rows(v, fin, fu, sai, sm, wr, wc, fr, fq, scr); E.finish(fu, lds, tid, sel); }
        }
        if (!has_next) break;
        if (do_epi) {
#pragma unroll
        for (int a = 0; a < 2; ++a)
#pragma unroll
            for (int b = 0; b < 2; ++b)
#pragma unroll
                for (int m = 0; m < 4; ++m)
#pragma unroll
                    for (int n = 0; n < 2; ++n) acc[a][b][m][n] = (f32x4){0.f, 0.f, 0.f, 0.f};
        }
        cur = nxt; cA = nA; cB = nB; ++ui;
        if (wr == 1) PG8_BAR;
    }
    PG8_WAIT_V(0);
    PG8_BAR;
#undef PG8_SA
#undef PG8_SB
#undef PG8_STAGE
#undef PG8_LDA
#undef PG8_LDB
#undef PG8_MMA
#undef PG8_WAIT_V
#undef PG8_WAIT_L
#undef PG8_BAR
#undef PG8_SCHED
}
}

constexpr size_t MiB = 1u << 20;
constexpr size_t WS_CTL = 0, CTL_ZERO_BYTES = 128 * 1024;
constexpr size_t WS_SS = 1 * MiB;
constexpr size_t SS_BYTES = (size_t)M * 4 * 4;
constexpr size_t WS_W1T = 3 * MiB, WS_W3T = 7 * MiB, WS_TOEP = 11 * MiB, WS_LAM = 12 * MiB;
constexpr size_t WS_WGU = 13 * MiB;
constexpr size_t WS_WD = 24 * MiB;
constexpr size_t WS_WIN = WS_WD + (size_t)D * FF * 2;
constexpr size_t WS_WCO = WS_WIN + (size_t)NIN * D * 2;
constexpr size_t WS_WGLU = WS_WCO + (size_t)D * D * 2;
constexpr size_t WS_WO = WS_WGLU + (size_t)2 * D * D * 2;
constexpr size_t WS_XA = 50 * MiB;
constexpr size_t SLOT = (size_t)M * D * 2;
constexpr size_t WS_R = 84 * MiB;
constexpr size_t WS_END = WS_R + 5 * SLOT;
static_assert(WS_WO + (size_t)D * D * 2 <= WS_XA && WS_XA + SLOT <= WS_R && WS_END <= 256 * MiB && (size_t)M * FF * 2 <= 4 * SLOT, "d_ws map");
constexpr int CW_BAR = 1024;
constexpr int CW_FIN = 16384;
constexpr int CW_ZF = 4992;
constexpr int CW_CNT = 5120;

#define XB_TMO      128
#define XB_XCNT(j)  (256  + 64 * (j))
#define XB_XSUB(j)  (1280 + 64 * (j))
#define XB_XGEN(j)  (2304 + 64 * (j))
#define XB_TOP      3328
#define XB_TOPGEN   3392
#define XCD_BAR_WORDS 3456
#define XB_SPIN_CAP (1u << 20)
__device__ __forceinline__ unsigned xb_ld(unsigned* p)              { return __hip_atomic_load(p, __ATOMIC_RELAXED, __HIP_MEMORY_SCOPE_AGENT); }
__device__ __forceinline__ unsigned xb_add(unsigned* p, unsigned v) { return __hip_atomic_fetch_add(p, v, __ATOMIC_RELAXED, __HIP_MEMORY_SCOPE_AGENT); }
__device__ __forceinline__ unsigned xb_xcc_id() { return (unsigned)__builtin_amdgcn_s_getreg((3 << 11) | 20) & 0xFu; }
#define XB_SPIN(cond, bar) do { unsigned _sp = 0; while (cond) { __builtin_amdgcn_s_sleep(1); \
    if ((++_sp & 255u) == 0u) { if (xb_ld(&(bar)[XB_TMO])) break; if (_sp > XB_SPIN_CAP) { atomicAdd(&(bar)[XB_TMO], 1u); break; } } } } while (0)
struct XcdBarrier { unsigned* bar; unsigned x; volatile LAS unsigned* st; };
__device__ __forceinline__ XcdBarrier xcd_barrier_post(unsigned* bar, volatile LAS unsigned* st) {
    XcdBarrier b; b.bar = bar; b.x = xb_xcc_id(); b.st = st;
    if (threadIdx.x == 0) (void)xb_add(&bar[XB_XCNT(b.x)], 1u);
    return b;
}
__device__ __forceinline__ void xcd_barrier_complete(unsigned* bar, unsigned x, unsigned& nloc, unsigned& nx) {
    const unsigned G = gridDim.x * gridDim.y * gridDim.z;
    unsigned sum, cnt, mine, sp = 0u;
    for (;;) {
        sum = 0u; cnt = 0u; mine = 0u;
#pragma unroll
        for (unsigned j = 0; j < 16; ++j) { const unsigned c = xb_ld(&bar[XB_XCNT(j)]); sum += c; cnt += (c > 0u) ? 1u : 0u; mine = (j == x) ? c : mine; }
        if (sum == G) break;
        __builtin_amdgcn_s_sleep(1);
        if ((++sp & 255u) == 0u) { if (xb_ld(&bar[XB_TMO])) break; if (sp > XB_SPIN_CAP) { atomicAdd(&bar[XB_TMO], 1u); break; } }
    }
    nloc = mine > 0u ? mine : 1u; nx = cnt > 0u ? cnt : 1u;
}
__device__ __forceinline__ void xcd_barrier(const XcdBarrier& b) {
    asm volatile("s_waitcnt vmcnt(0)" ::: "memory");
    __syncthreads();
    if (threadIdx.x == 0) {
        unsigned* bar = b.bar;
        __builtin_amdgcn_s_waitcnt(0);
        unsigned nloc = b.st[0], nx = b.st[1];
        if (nloc == 0u) { xcd_barrier_complete(bar, b.x, nloc, nx); b.st[0] = nloc; b.st[1] = nx; }
        const unsigned old = xb_add(&bar[XB_XSUB(b.x)], 1u);
        const unsigned gen = old / nloc;
        if (old + 1u == (gen + 1u) * nloc) {
            __builtin_amdgcn_fence(__ATOMIC_RELEASE, "agent");
            asm volatile("s_waitcnt vmcnt(0)" ::: "memory");
            const unsigned og = xb_add(&bar[XB_TOP], 1u);
            const unsigned tg = og / nx;
            if (og + 1u == (tg + 1u) * nx) xb_add(&bar[XB_TOPGEN], 1u);
            else XB_SPIN(xb_ld(&bar[XB_TOPGEN]) == tg, bar);
            __builtin_amdgcn_fence(__ATOMIC_ACQUIRE, "agent");
            xb_add(&bar[XB_XGEN(b.x)], 1u);
            asm volatile("s_waitcnt vmcnt(0)" ::: "memory");
        } else {
            XB_SPIN(xb_ld(&bar[XB_XGEN(b.x)]) == gen, bar);
            __builtin_amdgcn_fence(__ATOMIC_ACQUIRE, "agent");
            asm volatile("s_waitcnt vmcnt(0)" ::: "memory");
        }
    }
    __syncthreads();
}

struct Args {
    const float* in[28]; float* out; unsigned char* ws; int ph_lo, ph_hi;
};
#define LDS_WAIT() asm volatile("s_waitcnt lgkmcnt(0)" ::: "memory")

__device__ __forceinline__ float wave_sum(float v) {
#pragma unroll
    for (int o = 1; o < 64; o <<= 1) v += __shfl_xor(v, o);
    return v;
}

__device__ __forceinline__ void transpose_item(const float* W, int N, bf16_t* WT, int K, int drow0, const float* gain, LAS float* scr, int k0, int n0, int lane) {
    const int l15 = lane & 15, q = lane >> 4;
    f32x4 v[16];
#pragma unroll
    for (int i = 0; i < 16; ++i) v[i] = *(const f32x4*)(W + (size_t)(k0 + 4 * i + q) * N + n0 + 4 * l15);
#pragma unroll
    for (int i = 0; i < 16; ++i) { const int kk = 4 * i + q; const float gsc = gain ? gain[k0 + kk] : 1.0f; LAS float* d = scr + kk * 65 + 4 * l15;
        d[0] = v[i][0] * gsc; d[1] = v[i][1] * gsc; d[2] = v[i][2] * gsc; d[3] = v[i][3] * gsc; }
    LDS_WAIT(); asm volatile("" ::: "memory");
    const int c = lane & 7;
#pragma unroll
    for (int j = 0; j < 8; ++j) { const int n = (lane >> 3) + 8 * j; const LAS float* sp = scr + (8 * c) * 65 + n;
        u32x4 o; o.x = cvt_pk_bf16(sp[0 * 65], sp[1 * 65]); o.y = cvt_pk_bf16(sp[2 * 65], sp[3 * 65]); o.z = cvt_pk_bf16(sp[4 * 65], sp[5 * 65]); o.w = cvt_pk_bf16(sp[6 * 65], sp[7 * 65]);
        *(u32x4*)(WT + (size_t)(drow0 + n) * K + k0 + 8 * c) = o; }
    LDS_WAIT(); asm volatile("" ::: "memory");
}
__device__ __forceinline__ int pair_lo(int n) { return 256 * (n >> 7) + (n & 127); }
__device__ __forceinline__ int pair_hi(int n) { return 256 * (n >> 7) + 128 + (n & 127); }
constexpr int IT_GU = (D / 64) * (FF / 64), IT_DN = (FF / 64) * (D / 64), IT_FFN = 2 * IT_GU + IT_DN;
__device__ __forceinline__ void conv_ffn_item(int r, const float* wg, const float* wu, const float* wd, const float* gain, bf16_t* WGU, bf16_t* WDt, LAS float* scr, int lane) {
    if (r < IT_GU) { const int kb = r / (FF / 64), nb = r % (FF / 64); transpose_item(wg, FF, WGU, D, pair_lo(64 * nb), gain, scr, 64 * kb, 64 * nb, lane); return; } r -= IT_GU;
    if (r < IT_GU) { const int kb = r / (FF / 64), nb = r % (FF / 64); transpose_item(wu, FF, WGU, D, pair_hi(64 * nb), gain, scr, 64 * kb, 64 * nb, lane); return; } r -= IT_GU;
    { const int kb = r / (D / 64), nb = r % (D / 64); transpose_item(wd, D, WDt, FF, 64 * nb, nullptr, scr, 64 * kb, 64 * nb, lane); }
}

constexpr int IT_WIN = (D / 64) * (NIN / 64), IT_CO = (D / 64) * (D / 64), IT_GLU = (D / 64) * (2 * D / 64), IT_O = IT_CO;
constexpr int ITB_FFN2 = IT_FFN, ITB_WIN = 2 * IT_FFN, ITB_CO = ITB_WIN + IT_WIN, ITB_GLU = ITB_CO + IT_CO, ITB_O = ITB_GLU + IT_GLU, ITB_END = ITB_O + IT_O;
__device__ __forceinline__ void conv_range(const Args& a, LAS unsigned char* lds, int lo, int hi, int idx, int n, int wave, int lane) {
    unsigned char* ws = a.ws; LAS float* scr = (LAS float*)(lds + wave * 16896);
    bf16_t* WGU = (bf16_t*)(ws + WS_WGU); bf16_t* WDt = (bf16_t*)(ws + WS_WD); bf16_t* WIN = (bf16_t*)(ws + WS_WIN); bf16_t* WCO = (bf16_t*)(ws + WS_WCO); bf16_t* WGLU = (bf16_t*)(ws + WS_WGLU); bf16_t* WOt = (bf16_t*)(ws + WS_WO);
    bf16_t* WGU1 = (bf16_t*)a.out; bf16_t* WD1 = WGU1 + (size_t)2 * FF * D;
    for (int it = lo + idx; it < hi; it += n) {
        int r = it;
        if (r < IT_FFN) { conv_ffn_item(r, a.in[6], a.in[7], a.in[8], a.in[5], WGU1, WD1, scr, lane); continue; } r -= IT_FFN;
        if (r < IT_FFN) { conv_ffn_item(r, a.in[24], a.in[25], a.in[26], a.in[23], WGU, WDt, scr, lane); continue; } r -= IT_FFN;
        if (r < IT_WIN) { const int kb = r / (NIN / 64), nb = r % (NIN / 64), n0 = 64 * nb; const int dr = n0 < 1024 ? pair_lo(n0) : (n0 < 2048 ? pair_hi(n0 - 1024) : n0);
            transpose_item(a.in[10], NIN, WIN, D, dr, a.in[9], scr, 64 * kb, n0, lane); continue; } r -= IT_WIN;
        if (r < IT_CO) { const int kb = r / (D / 64), nb = r % (D / 64); transpose_item(a.in[12], D, WCO, D, 64 * nb, nullptr, scr, 64 * kb, 64 * nb, lane); continue; } r -= IT_CO;
        if (r < IT_GLU) { const int kb = r / (2 * D / 64), nb = r % (2 * D / 64), n0 = 64 * nb; const int dr = n0 < 1024 ? pair_lo(n0) : pair_hi(n0 - 1024);
            transpose_item(a.in[21], 2 * D, WGLU, D, dr, nullptr, scr, 64 * kb, n0, lane); continue; } r -= IT_GLU;
        { const int kb = r / (D / 64), nb = r % (D / 64); transpose_item(a.in[22], D, WOt, D, 64 * nb, nullptr, scr, 64 * kb, 64 * nb, lane); }
    }
}

typedef float cplx __attribute__((ext_vector_type(2)));
#define CX(a, b) ((cplx){(a), (b)})
__device__ __forceinline__ cplx cmul(cplx a, cplx b) { return CX(a.x * b.x - a.y * b.y, a.x * b.y + a.y * b.x); }
__device__ __forceinline__ cplx cfma(cplx a, cplx b, cplx c) { return CX(fmaf(a.x, b.x, fmaf(-a.y, b.y, c.x)), fmaf(a.x, b.y, fmaf(a.y, b.x, c.y))); }

__device__ __forceinline__ void ssm_tables_job(const Args& a, LAS unsigned char* lds, int g, int part, int tid) {
    LAS cplx* pw = (LAS cplx*)lds;
    LAS cplx* bb = pw + 17 * 64;
    LAS cplx* cc = bb + 64 * 16;
    LAS float* kt = (LAS float*)(cc + 16 * 64);
    const float* lam_re = a.in[13] + g * NP; const float* lam_im = a.in[14] + g * NP; const float stepv = expf(a.in[15][g]);
    const float* b_re = a.in[16] + (size_t)g * NP * 16; const float* b_im = a.in[17] + (size_t)g * NP * 16;
    const float* c_re = a.in[18] + (size_t)g * 16 * NP; const float* c_im = a.in[19] + (size_t)g * 16 * NP; const float* dsk = a.in[20] + g * 16;
    unsigned char* ws = a.ws;
    for (int idx = tid; idx < 17 * 64; idx += 512) { const int tau = idx >> 6, p = idx & 63;
        const float zr = (float)tau * stepv * lam_re[p]; const double zt = (double)tau * (double)stepv * (double)lam_im[p] * 0.15915494309189535;
        const float rt = (float)(zt - rint(zt));
        const float mag = __builtin_amdgcn_exp2f(zr * 1.4426950409f); pw[idx] = CX(mag * __builtin_amdgcn_cosf(rt), mag * __builtin_amdgcn_sinf(rt)); }
    for (int idx = tid; idx < 64 * 16; idx += 512) { const int p = idx >> 4;
        const float lr = lam_re[p], li = lam_im[p], zr = stepv * lr; const double zt = (double)stepv * (double)li * 0.15915494309189535; const float rt = (float)(zt - rint(zt));
        const float ex1 = zr * (1.0f + zr * (0.5f + zr * (0.16666667f + zr * (0.041666668f + zr * 0.0083333338f))));
        const float sn = __builtin_amdgcn_sinf(rt), cs = __builtin_amdgcn_cosf(rt), sh = __builtin_amdgcn_sinf(0.5f * rt);
        const float nr = ex1 * cs - 2.0f * sh * sh, ni = (ex1 + 1.0f) * sn;
        const float den = 1.0f / (lr * lr + li * li); const cplx q = CX((nr * lr + ni * li) * den, (ni * lr - nr * li) * den);
        bb[idx] = cmul(q, CX(b_re[idx], b_im[idx])); }
    for (int idx = tid; idx < 16 * 64; idx += 512) cc[idx] = CX(c_re[idx], c_im[idx]);
    __syncthreads();
    {
        bf16_t* W1T = (bf16_t*)(ws + WS_W1T) + (size_t)g * 32768;
        for (int o8 = part * 1024 + tid; o8 < part * 1024 + 1024; o8 += 512) { const int lane = o8 & 63, nt = (o8 >> 6) & 7, ks = o8 >> 9; const int n = nt * 16 + (lane & 15), p = n & 63, isim = n >> 6; float v[8];
#pragma unroll
            for (int jj = 0; jj < 8; ++jj) { const int kk = ks * 32 + 8 * (lane >> 4) + jj, j = kk >> 4, c1 = kk & 15; const cplx pr = cmul(pw[(15 - j) * 64 + p], bb[p * 16 + c1]); v[jj] = isim ? pr.y : pr.x; }
            u32x4 w; w.x = cvt_pk_bf16(v[0], v[1]); w.y = cvt_pk_bf16(v[2], v[3]); w.z = cvt_pk_bf16(v[4], v[5]); w.w = cvt_pk_bf16(v[6], v[7]);
            *(u32x4*)(W1T + (size_t)o8 * 8) = w; }
        bf16_t* W3T = (bf16_t*)(ws + WS_W3T) + (size_t)g * 32768;
        for (int o8 = part * 1024 + tid; o8 < part * 1024 + 1024; o8 += 512) { const int lane = o8 & 63, i = (o8 >> 6) & 15, ks = o8 >> 10; const int c = lane & 15; float v[8];
#pragma unroll
            for (int jj = 0; jj < 8; ++jj) { const int k = ks * 32 + 8 * (lane >> 4) + jj, p = k & 63, isim = k >> 6; const cplx cl = cmul(cc[c * 64 + p], pw[(i + 1) * 64 + p]); v[jj] = isim ? -cl.y : cl.x; }
            u32x4 w; w.x = cvt_pk_bf16(v[0], v[1]); w.y = cvt_pk_bf16(v[2], v[3]); w.z = cvt_pk_bf16(v[4], v[5]); w.w = cvt_pk_bf16(v[6], v[7]);
            *(u32x4*)(W3T + (size_t)o8 * 8) = w; }
        float* KT = (float*)(ws + WS_TOEP) + (size_t)g * 4096;
        for (int idx = part * 1024 + tid; idx < part * 1024 + 1024; idx += 512) { const int tau = idx >> 8, c = (idx >> 4) & 15, c1 = idx & 15; float sa = 0.f, sb = 0.f;
#pragma unroll 8
            for (int p = 0; p < 64; p += 2) { const cplx t0 = cmul(cc[c * 64 + p], pw[tau * 64 + p]), b0 = bb[p * 16 + c1], t1 = cmul(cc[c * 64 + p + 1], pw[tau * 64 + p + 1]), b1 = bb[(p + 1) * 16 + c1];
                sa += t0.x * b0.x - t0.y * b0.y; sb += t1.x * b1.x - t1.y * b1.y; }
            float sv = sa + sb; if (tau == 0 && c == c1) sv += dsk[c];
            KT[idx] = sv; }
        if (part == 0 && tid < 64) ((cplx*)(ws + WS_LAM))[g * 64 + tid] = pw[16 * 64 + tid];
    }
    __syncthreads();
}

constexpr int L_US = 0, L_SL = 67584, L_SIN = 101376, L_TOEP = 118784, L_ASEG = 135168, L_CARRY = 139264;
struct SsmFrags { bf16x8 w1[8]; bf16x8 w3[2][4]; cplx lam; };
#define LBAR() do { asm volatile("s_waitcnt lgkmcnt(0)" ::: "memory"); __builtin_amdgcn_s_barrier(); asm volatile("" ::: "memory"); } while (0)
template <bool SAMPLE>
__device__ __forceinline__ void ssm_tile(const Args& a, LAS unsigned char* lds, int g, int row0, int tile, bool first, bool last, int seq, const SsmFrags& F, bool has_next_tile, int tid, bf16_t* Yg) {
    const int wid = __builtin_amdgcn_readfirstlane(tid >> 6), lane = tid & 63, l15 = lane & 15, q = lane >> 4;
    unsigned char* ws = a.ws;
    bf16_t* Ug = (bf16_t*)(ws + WS_R + 2 * SLOT) + ((size_t)g * M + row0) * 16;
    const int ub = L_US + (tile & 1) * 33792, ubn = L_US + ((tile + 1) & 1) * 33792;
    u32x4 pf[4];
    if (has_next_tile) {
#pragma unroll
        for (int k = 0; k < 4; ++k) pf[k] = ((const u32x4*)(Ug + 16384))[tid + 512 * k]; }
#pragma unroll
    for (int rb = 0; rb < 4; ++rb) { f32x4 acc = {0.f, 0.f, 0.f, 0.f};
#pragma unroll
        for (int ks = 0; ks < 8; ++ks) { const bf16x8 av = *(const LAS bf16x8*)(lds + ub + (rb * 16 + l15) * 528 + ks * 64 + q * 16); acc = __builtin_amdgcn_mfma_f32_16x16x32_bf16(F.w1[ks], av, acc, 0, 0, 0); }
        *(LAS f32x4*)(lds + L_SL + ((rb * 16 + l15) * 132 + wid * 16 + q * 4) * 4) = acc; }
    LBAR();
    {
        const int p = lane, seg = wid; const LAS float* Sl = (const LAS float*)(lds + L_SL); LAS bf16_t* Sin = (LAS bf16_t*)(lds + L_SIN);
        const cplx L1 = F.lam;
        if (!SAMPLE) {
            LAS cplx* Aseg = (LAS cplx*)(lds + L_ASEG); LAS cplx* carry = (LAS cplx*)(lds + L_CARRY);
            cplx sv[8];
#pragma unroll
            for (int c = 0; c < 8; ++c) { const int ch = seg * 8 + c; sv[c] = CX(Sl[ch * 132 + p], Sl[ch * 132 + 64 + p]); }
            cplx acc = CX(0.f, 0.f);
#pragma unroll
            for (int c = 0; c < 8; ++c) acc = cfma(L1, acc, sv[c]);
            Aseg[seg * 64 + p] = acc;
            LBAR();
            const cplx L2 = cmul(L1, L1), L4 = cmul(L2, L2), L8 = cmul(L4, L4);
            cplx x = first ? CX(0.f, 0.f) : carry[(tile & 1) * 64 + p];
            for (int s = 0; s < seg; ++s) x = cfma(L8, x, Aseg[s * 64 + p]);
#pragma unroll
            for (int c = 0; c < 8; ++c) { const int ch = seg * 8 + c; Sin[ch * 136 + p] = (bf16_t)(cvt_pk_bf16(x.x, 0.f) & 0xffffu); Sin[ch * 136 + 64 + p] = (bf16_t)(cvt_pk_bf16(x.y, 0.f) & 0xffffu);
                x = cfma(L1, x, sv[c]); }
            if (seg == 7) { carry[((tile + 1) & 1) * 64 + p] = x;
                if (last) { a.out[O_SREP + ((size_t)seq * NG + g) * NP + p] = x.x; a.out[O_SIMP + ((size_t)seq * NG + g) * NP + p] = x.y; } }
        } else {
#pragma unroll
            for (int sq = 0; sq < 4; ++sq) { const int s = seg * 4 + sq; const size_t so = ((size_t)s * NG + g) * NP + p;
                cplx x = CX(a.in[3][so], a.in[4][so]);
#pragma unroll
                for (int c = 0; c < 2; ++c) { const int ch = 2 * s + c; Sin[ch * 136 + p] = (bf16_t)(cvt_pk_bf16(x.x, 0.f) & 0xffffu); Sin[ch * 136 + 64 + p] = (bf16_t)(cvt_pk_bf16(x.y, 0.f) & 0xffffu);
                    x = cfma(L1, x, CX(Sl[ch * 132 + p], Sl[ch * 132 + 64 + p])); }
                a.out[O_SRES + so] = x.x; a.out[O_SIMS + so] = x.y; }
        }
    }
    LBAR();
    {
        f32x4 acc[2][4];
#pragma unroll
        for (int t2 = 0; t2 < 2; ++t2)
#pragma unroll
            for (int rb = 0; rb < 4; ++rb) acc[t2][rb] = (f32x4){0.f, 0.f, 0.f, 0.f};
#pragma unroll
        for (int ks = 0; ks < 4; ++ks)
#pragma unroll
            for (int rb = 0; rb < 4; ++rb) { const bf16x8 av = *(const LAS bf16x8*)(lds + L_SIN + (rb * 16 + l15) * 272 + ks * 64 + q * 16);
                acc[0][rb] = __builtin_amdgcn_mfma_f32_16x16x32_bf16(F.w3[0][ks], av, acc[0][rb], 0, 0, 0); acc[1][rb] = __builtin_amdgcn_mfma_f32_16x16x32_bf16(F.w3[1][ks], av, acc[1][rb], 0, 0, 0); }
#pragma unroll
        for (int t2 = 0; t2 < 2; ++t2) { const int i = t2 ? 15 - wid : wid; const int ns = (i >> 1) + 1;
            bf16x8 bfc = *(const LAS bf16x8*)(lds + L_TOEP + (i * 64 + lane) * 16); bf16x8 avc[4];
#pragma unroll
            for (int rb = 0; rb < 4; ++rb) avc[rb] = *(const LAS bf16x8*)(lds + ub + (rb * 16 + l15) * 528 + q * 16);
            for (int s2 = 0; s2 < ns; ++s2) { const int sn = (s2 + 1 < ns) ? s2 + 1 : s2;
                const bf16x8 bfn = *(const LAS bf16x8*)(lds + L_TOEP + ((i - 2 * sn) * 64 + lane) * 16); bf16x8 avn[4];
#pragma unroll
                for (int rb = 0; rb < 4; ++rb) avn[rb] = *(const LAS bf16x8*)(lds + ub + (rb * 16 + l15) * 528 + sn * 64 + q * 16);
#pragma unroll
                for (int rb = 0; rb < 4; ++rb) acc[t2][rb] = __builtin_amdgcn_mfma_f32_16x16x32_bf16(bfc, avc[rb], acc[t2][rb], 0, 0, 0);
                bfc = bfn;
#pragma unroll
                for (int rb = 0; rb < 4; ++rb) avc[rb] = avn[rb]; }
#pragma unroll
            for (int rb = 0; rb < 4; ++rb) { u32x2 w; w.x = cvt_pk_bf16(gelu_tanh_f(acc[t2][rb][0]), gelu_tanh_f(acc[t2][rb][1])); w.y = cvt_pk_bf16(gelu_tanh_f(acc[t2][rb][2]), gelu_tanh_f(acc[t2][rb][3]));
                *(LAS u32x2*)(lds + L_SL + (rb * 16 + l15) * 528 + i * 32 + q * 8) = w; } }
    }
    LBAR();
#pragma unroll
    for (int k = 0; k < 4; ++k) { const int i = tid + 512 * k; const u32x4 v = *(const LAS u32x4*)(lds + L_SL + (i >> 5) * 528 + (i & 31) * 16); ((u32x4*)Yg)[i] = v; }
    if (has_next_tile) {
#pragma unroll
        for (int k = 0; k < 4; ++k) { const int i = tid + 512 * k; *(LAS u32x4*)(lds + ubn + (i >> 5) * 528 + (i & 31) * 16) = pf[k]; } }
    LBAR();
}
__device__ __forceinline__ void ssm_item_begin(const Args& a, LAS unsigned char* lds, int g, int row0, SsmFrags& F, int tid) {
    const int wid = __builtin_amdgcn_readfirstlane(tid >> 6), lane = tid & 63;
    unsigned char* ws = a.ws;
    const bf16_t* W1T = (const bf16_t*)(ws + WS_W1T) + (size_t)g * 32768; const bf16_t* W3T = (const bf16_t*)(ws + WS_W3T) + (size_t)g * 32768;
    const bf16_t* Ug = (const bf16_t*)(ws + WS_R + 2 * SLOT) + ((size_t)g * M + row0) * 16;
    u32x4 uv[4]; f32x4 ka[2][2];
#pragma unroll
    for (int k = 0; k < 4; ++k) uv[k] = ((const u32x4*)Ug)[tid + 512 * k];
    const float* KT = (const float*)(ws + WS_TOEP) + (size_t)g * 4096;
#pragma unroll
    for (int k = 0; k < 2; ++k) { const int o8 = tid + 512 * k, ln = o8 & 63, d = o8 >> 6, qq = ln >> 4, dd = d - (qq >> 1); const float* src = KT + (dd < 0 ? 0 : dd) * 256 + (ln & 15) * 16 + 8 * (qq & 1);
        ka[k][0] = *(const f32x4*)src; ka[k][1] = *(const f32x4*)(src + 4); if (dd < 0) { ka[k][0] = (f32x4){0.f, 0.f, 0.f, 0.f}; ka[k][1] = (f32x4){0.f, 0.f, 0.f, 0.f}; } }
#pragma unroll
    for (int ks = 0; ks < 8; ++ks) F.w1[ks] = *(const bf16x8*)(W1T + ((size_t)(ks * 8 + wid) * 64 + lane) * 8);
#pragma unroll
    for (int t2 = 0; t2 < 2; ++t2) { const int i = t2 ? 15 - wid : wid;
#pragma unroll
        for (int ks = 0; ks < 4; ++ks) F.w3[t2][ks] = *(const bf16x8*)(W3T + ((size_t)(ks * 16 + i) * 64 + lane) * 8); }
    F.lam = ((const cplx*)(ws + WS_LAM))[g * 64 + lane];
#pragma unroll
    for (int k = 0; k < 4; ++k) { const int i = tid + 512 * k; *(LAS u32x4*)(lds + L_US + (i >> 5) * 528 + (i & 31) * 16) = uv[k]; }
#pragma unroll
    for (int k = 0; k < 2; ++k) { u32x4 w; w.x = cvt_pk_bf16(ka[k][0][0], ka[k][0][1]); w.y = cvt_pk_bf16(ka[k][0][2], ka[k][0][3]); w.z = cvt_pk_bf16(ka[k][1][0], ka[k][1][1]); w.w = cvt_pk_bf16(ka[k][1][2], ka[k][1][3]);
        *(LAS u32x4*)(lds + L_TOEP + (tid + 512 * k) * 16) = w; }
    LDS_WAIT(); __syncthreads();
}

typedef float f32x8 __attribute__((ext_vector_type(8)));
__device__ __forceinline__ f32x8 bf8_to_f32(u32x4 v) { return (f32x8){bf_lo(v.x), bf_hi(v.x), bf_lo(v.y), bf_hi(v.y), bf_lo(v.z), bf_hi(v.z), bf_lo(v.w), bf_hi(v.w)}; }
__device__ __forceinline__ f32x8 ld_f32x8(const float* p) { const f32x4 a = *(const f32x4*)p, b = *(const f32x4*)(p + 4); return (f32x8){a[0], a[1], a[2], a[3], b[0], b[1], b[2], b[3]}; }
template <int NR>
__device__ __forceinline__ void conv_rows(const float* cstate, const bf16_t* Z, const bf16_t* BG, bf16_t* ZC, int r0, int c0, f32x8 w0, f32x8 w1, f32x8 w2, f32x8& z1, f32x8& z2) {
    u32x4 zv[NR], bv[NR];
#pragma unroll
    for (int rr = 0; rr < NR; ++rr) { zv[rr] = *(const u32x4*)(Z + (size_t)(r0 + rr) * D + c0); bv[rr] = *(const u32x4*)(BG + (size_t)(r0 + rr) * D + c0); }
#pragma unroll
    for (int rr = 0; rr < NR; ++rr) { const int row = r0 + rr;
        const bool st = (row < MP) ? ((row & 4095) == 0) : (((row - MP) & 31) == 0);
        if (st) { if (row < MP) { z1 = (f32x8)(0.f); z2 = (f32x8)(0.f); }
            else { const int s = (row - MP) >> 5; const float* pv = cstate + (size_t)s * 2 * D + c0; z2 = ld_f32x8(pv); z1 = ld_f32x8(pv + D); } }
        const f32x8 z0 = bf8_to_f32(zv[rr]), b0 = bf8_to_f32(bv[rr]);
        const f32x8 o = b0 * (w0 * z2 + w1 * z1 + w2 * z0); z2 = z1; z1 = z0;
        u32x4 w; w.x = cvt_pk_bf16(o[0], o[1]); w.y = cvt_pk_bf16(o[2], o[3]); w.z = cvt_pk_bf16(o[4], o[5]); w.w = cvt_pk_bf16(o[6], o[7]);
        *(u32x4*)(ZC + (size_t)row * D + c0) = w; }
}

constexpr int NPHASE = 10;
__global__ void __launch_bounds__(512, 2) mk_fwd(Args a) {
    extern __shared__ __attribute__((aligned(16))) unsigned char lds_raw[];
    LAS unsigned char* lds = (LAS unsigned char*)lds_raw;
    const int tid = threadIdx.x, lane = tid & 63, wave = __builtin_amdgcn_readfirstlane(tid >> 6);
    const int G = gridDim.x; const int bx = blockIdx.x; const int vcu = (G % 8 == 0) ? (bx % 8) * (G / 8) + bx / 8 : bx;
    unsigned char* ws = a.ws;
    volatile LAS unsigned* MISC = (volatile LAS unsigned*)(lds + LDSCTL_OFF);
    if (tid < 64) MISC[tid] = 0u;
    __syncthreads();
    XcdBarrier bar; bar.bar = (unsigned*)(ws + WS_CTL) + CW_BAR; bar.x = 0; bar.st = nullptr;
    const int lo = a.ph_lo, hi = a.ph_hi;
    if (hi - lo > 1) bar = xcd_barrier_post((unsigned*)(ws + WS_CTL) + CW_BAR, MISC + 8);
#define IN(k) (lo <= (k) && (k) < hi)
#define SEAM(k) do { if (IN(k) && IN((k) + 1)) xcd_barrier(bar); } while (0)
#ifndef DUP_PHASE
#define DUP_PHASE -1
#endif
#define REPS(k) ((DUP_PHASE) == (k) ? 2 : 1)
#define REP(k) for (int rep_ = 0; rep_ < REPS(k); ++rep_, (rep_ < REPS(k) ? xcd_barrier(bar) : (void)0))

    bf16_t* WGU = (bf16_t*)(ws + WS_WGU); bf16_t* WDt = (bf16_t*)(ws + WS_WD); bf16_t* WIN = (bf16_t*)(ws + WS_WIN); bf16_t* WCO = (bf16_t*)(ws + WS_WCO);
    bf16_t* WGLU = (bf16_t*)(ws + WS_WGLU); bf16_t* WOt = (bf16_t*)(ws + WS_WO); bf16_t* XA = (bf16_t*)(ws + WS_XA);
    bf16_t* R0 = (bf16_t*)(ws + WS_R); bf16_t* R1 = (bf16_t*)(ws + WS_R + SLOT); bf16_t* R2 = (bf16_t*)(ws + WS_R + 2 * SLOT); bf16_t* R3 = (bf16_t*)(ws + WS_R + 3 * SLOT); bf16_t* R4 = (bf16_t*)(ws + WS_R + 4 * SLOT);
    bf16_t* HB = R0;
    bf16_t* WGU1 = (bf16_t*)a.out; bf16_t* WD1 = WGU1 + (size_t)2 * FF * D;
    float* ss0 = (float*)(ws + WS_SS); float* ss1 = (float*)(ws + WS_SS + SS_BYTES); float* ss2 = (float*)(ws + WS_SS + 2 * SS_BYTES); float* ss3 = (float*)(ws + WS_SS + 3 * SS_BYTES);
    float* Y = a.out + O_Y;
    u32x2* PD2 = (u32x2*)((unsigned char*)a.out + 17 * MiB); u32x2* PDO = (u32x2*)a.out; u32x2* PD9 = (u32x2*)(ws + WS_XA);
    const int gw = vcu * 8 + wave, NGW = G * 8;

    if (IN(0)) REP(0) {
        const bool tables_first = (bx & 1) != 0;
        if (tables_first) for (int job = vcu; job < NG * 4; job += G) ssm_tables_job(a, lds, job >> 2, job & 3, tid);
        conv_range(a, lds, 0, 2 * IT_GU, gw, NGW, wave, lane);
        for (int m0 = gw; m0 < M; m0 += 4 * NGW) {
            f32x4 v[4][4]; int mr[4];
#pragma unroll
            for (int r = 0; r < 4; ++r) { const int m = m0 + r * NGW; mr[r] = m < M ? m : m0; const float* xr = (mr[r] < MP) ? a.in[0] + (size_t)mr[r] * D : a.in[1] + (size_t)(mr[r] - MP) * D;
#pragma unroll
                for (int j = 0; j < 4; ++j) v[r][j] = ((const f32x4*)xr)[lane + 64 * j]; }
#pragma unroll
            for (int r = 0; r < 4; ++r) { if (r > 0 && m0 + r * NGW >= M) break; float sq = 0.f;
#pragma unroll
                for (int j = 0; j < 4; ++j) sq += (v[r][j][0] * v[r][j][0] + v[r][j][1] * v[r][j][1]) + (v[r][j][2] * v[r][j][2] + v[r][j][3] * v[r][j][3]);
                sq = wave_sum(sq);
#pragma unroll
                for (int j = 0; j < 4; ++j) { u32x2 w; w.x = cvt_pk_bf16(v[r][j][0], v[r][j][1]); w.y = cvt_pk_bf16(v[r][j][2], v[r][j][3]); ((u32x2*)(XA + (size_t)mr[r] * D))[lane + 64 * j] = w; }
                if (lane == 0) *(f32x4*)(ss0 + (size_t)mr[r] * 4) = (f32x4){sq, 0.f, 0.f, 0.f}; }
        }
        __syncthreads();
        if (!tables_first) for (int job = vcu; job < NG * 4; job += G) ssm_tables_job(a, lds, job >> 2, job & 3, tid);
    }
    SEAM(0);
    if (IN(1)) REP(1) { pg8::Gemm g{XA, WGU1, M, 2 * FF, D, 2 * D, 32}; pg8::StaticOrder S; S.init(M, 2 * FF, D, G, bx, 1); pg8::EpiSwiGLU E{HB, ss0}; pg8::gemm_phase<false>(lds, g, S, E, nullptr, nullptr);
        if (S.r > 0 && bx >= S.r) { const int nw = (G - S.r) * 8; conv_range(a, lds, 2 * IT_GU, IT_FFN, (bx - S.r) * 8 + wave, nw, wave, lane); __syncthreads(); } }
    SEAM(1);
    if (IN(2)) REP(2) { pg8::Gemm g{HB, WD1, M, D, FF, 2 * FF, 32}; pg8::StaticOrder S; S.init(M, D, FF, G, bx, NSPLIT); pg8::EpiResid<true, false, true> E{nullptr, nullptr, XA, nullptr, XA, ss1, 0.5f};   pg8::gemm_phase<true>(lds, g, S, E, PD2, (unsigned*)(ws + WS_CTL) + CW_CNT + 0 * 2048);
        { const int nt_ = S.ns > 1 ? S.r * S.ns : 0; if (bx >= nt_ && nt_ < G) { const int nw = (G - nt_) * 8; conv_range(a, lds, ITB_WIN, (G - nt_ > NG) ? ITB_GLU : ITB_END, (bx - nt_) * 8 + wave, nw, wave, lane); __syncthreads(); } } }
    SEAM(2);
    if (IN(3)) { pg8::Gemm g{XA, WIN, M, NIN, D, 2 * D, 32}; pg8::ZFirstOrder S; unsigned* zdone = (unsigned*)(ws + WS_CTL) + CW_ZF; S.init(G, bx, zdone);
        pg8::EpiMixIn E{R0, R1, R2, (unsigned char*)R3, (unsigned char*)R4, ss1, a.out};
        pg8::gemm_phase<false>(lds, g, S, E, nullptr, nullptr);
        const int ntot = S.nA + S.nB, rlast = ntot - ((ntot - 1) / G) * G;
        const bool all_conv = (rlast == G);
        if (all_conv || bx >= rlast) {
            if (tid == 0) { unsigned sp = 0; while (__hip_atomic_load(zdone, __ATOMIC_RELAXED, __HIP_MEMORY_SCOPE_AGENT) < (unsigned)S.publishers()) { __builtin_amdgcn_s_sleep(2); if (++sp > (1u << 22)) break; }
                __builtin_amdgcn_fence(__ATOMIC_ACQUIRE, "agent"); asm volatile("s_waitcnt vmcnt(0)" ::: "memory"); }
            __syncthreads();
            const int cw = all_conv ? bx : bx - rlast, ncw = all_conv ? G : G - rlast, nruns = ncw * 4;
            const float* wc = a.in[11]; const float* cstate = a.in[2]; const bf16_t* Z = R0; bf16_t* BG = R1;
            const int run = cw * 4 + (tid >> 7), c0 = (tid & 127) * 8;
            const int r0 = (int)(((long)run * M) / nruns), r1 = (int)(((long)(run + 1) * M) / nruns);
            const f32x8 w0 = ld_f32x8(wc + c0), w1 = ld_f32x8(wc + D + c0), w2 = ld_f32x8(wc + 2 * D + c0); f32x8 z1 = (f32x8)(0.f), z2 = (f32x8)(0.f);
            { const bool st = (r0 < MP) ? ((r0 & 4095) == 0) : (((r0 - MP) & 31) == 0);
              if (!st) { const bool st1 = (r0 < MP) ? (((r0 - 1) & 4095) == 0) : (((r0 - 1 - MP) & 31) == 0);
                  z1 = bf8_to_f32(*(const u32x4*)(Z + (size_t)(r0 - 1) * D + c0));
                  if (!st1) z2 = bf8_to_f32(*(const u32x4*)(Z + (size_t)(r0 - 2) * D + c0));
                  else if (r0 - 1 >= MP) { const int sq = (r0 - 1 - MP) >> 5; z2 = ld_f32x8(cstate + ((size_t)sq * 2 + 1) * D + c0); } } }
            int r = r0;
            for (; r + 9 <= r1; r += 9) { int rr = r; asm volatile("" : "+v"(rr)); conv_rows<9>(cstate, Z, BG, BG, rr, c0, w0, w1, w2, z1, z2); }
            for (; r + 4 <= r1; r += 4) { int rr = r; asm volatile("" : "+v"(rr)); conv_rows<4>(cstate, Z, BG, BG, rr, c0, w0, w1, w2, z1, z2); }
            for (; r < r1; ++r) { int rr = r; asm volatile("" : "+v"(rr)); conv_rows<1>(cstate, Z, BG, BG, rr, c0, w0, w1, w2, z1, z2); }
        }
    }
    SEAM(3);

    if (IN(5)) { pg8::Gemm g{R1, WCO, M, D, D, 2 * D, 32}; pg8::StaticOrder S; S.init(M, D, D, G, bx, NSPLIT); pg8::EpiConvOut E{(const unsigned char*)R3, R0}; pg8::gemm_phase<true>(lds, g, S, E, PDO, (unsigned*)(ws + WS_CTL) + CW_CNT + 1 * 2048);
        { const int ntail = S.ns > 1 ? S.r * S.ns : 0;
          for (int item = vcu; item < NB * NG; item += G) { const int g = item & 63, seq = item >> 6; SsmFrags F; ssm_item_begin(a, lds, g, seq * SEQ, F, tid);
              for (int t = 0; t < 4; ++t) ssm_tile<false>(a, lds, g, seq * SEQ + t * 1024, t, t == 0, t == 3, seq, F, t < 3, tid, R2 + ((size_t)g * M + seq * SEQ + t * 1024) * 16); }
          const int nfree = G - ntail;
          for (int j = (bx >= ntail ? bx - ntail : bx + nfree); j < NG; j += G) { SsmFrags F; ssm_item_begin(a, lds, j, MP, F, tid); ssm_tile<true>(a, lds, j, MP, 0, true, true, 0, F, false, tid, R2 + ((size_t)j * M + MP) * 16); }
          if (nfree > NG && bx >= ntail + NG) { __syncthreads(); conv_range(a, lds, ITB_GLU, ITB_END, (bx - ntail - NG) * 8 + wave, (nfree - NG) * 8, wave, lane); __syncthreads(); }
        }
    }
    SEAM(5);
    if (IN(6)) REP(6) { pg8::Gemm g{R2, WGLU, M, 2 * D, D, 32, 32u * M}; pg8::StaticOrder S; S.init(M, 2 * D, D, G, bx, NSPLIT); pg8::EpiGlu E{R0, (const unsigned char*)R4, R0}; pg8::gemm_phase<true>(lds, g, S, E, PDO, (unsigned*)(ws + WS_CTL) + CW_CNT + 2 * 2048); }
    SEAM(6);
    if (IN(7)) { pg8::Gemm g{R0, WOt, M, D, D, 2 * D, 32}; pg8::StaticOrder S; S.init(M, D, D, G, bx, NSPLIT); pg8::EpiResid<true, false, true> E{nullptr, nullptr, XA, nullptr, R4, ss2, 1.0f}; pg8::gemm_phase<true>(lds, g, S, E, PDO, (unsigned*)(ws + WS_CTL) + CW_CNT + 3 * 2048);
        { const int nt_ = S.ns > 1 ? S.r * S.ns : 0; if (bx >= nt_ && nt_ < G) { conv_range(a, lds, ITB_FFN2, ITB_FFN2 + 2 * IT_GU, (bx - nt_) * 8 + wave, (G - nt_) * 8, wave, lane); __syncthreads(); } } }
    SEAM(7);
    if (IN(8)) REP(8) { pg8::Gemm g{R4, WGU, M, 2 * FF, D, 2 * D, 32}; pg8::StaticOrder S; S.init(M, 2 * FF, D, G, bx, 1); pg8::EpiSwiGLU E{HB, ss2}; pg8::gemm_phase<false>(lds, g, S, E, nullptr, nullptr);
        if (S.r > 0 && bx >= S.r) { conv_range(a, lds, ITB_FFN2 + 2 * IT_GU, ITB_WIN, (bx - S.r) * 8 + wave, (G - S.r) * 8, wave, lane); __syncthreads(); } else if (S.r == 0) { conv_range(a, lds, ITB_FFN2 + 2 * IT_GU, ITB_WIN, bx * 8 + wave, G * 8, wave, lane); __syncthreads(); } }
    SEAM(8);
    const bool fuse_final = (G == 256);
    if (IN(9)) { pg8::Gemm g{HB, WDt, M, D, FF, 2 * FF, 32}; pg8::StaticOrder S;
        if (fuse_final && S.init_tailpanels(M, D, FF, G, bx, MS / 256)) {
            unsigned* fc = (unsigned*)(ws + WS_CTL) + CW_FIN;
            pg8::EpiFinal E{R4, Y, ss3, fc, fc + 64 * (M / 256), a.in[27], 0.5f}; pg8::gemm_phase<true>(lds, g, S, E, PD9, (unsigned*)(ws + WS_CTL) + CW_CNT + 4 * 2048);
        }
    }
    SEAM(9);
#undef IN
#undef SEAM
}

extern "C" void kernel_launch(void* const* d_in, const int* in_sizes, int n_in, void* d_out, int out_size, void* d_ws, size_t ws_size, hipStream_t stream) {
    static int grid = 0;
    if (grid == 0) {
        if (n_in != 28 || ws_size < WS_END) { fprintf(stderr, "kernel_launch: unexpected inputs (n_in %d, ws %zu, need %zu)\n", n_in, ws_size, (size_t)WS_END); grid = -1; return; }
        int dev = 0, cus = 0;
        if (hipGetDevice(&dev) != hipSuccess || hipDeviceGetAttribute(&cus, hipDeviceAttributeMultiprocessorCount, dev) != hipSuccess) { grid = -1; return; }
        if (hipFuncSetAttribute((const void*)mk_fwd, hipFuncAttributeMaxDynamicSharedMemorySize, LDS_BYTES) != hipSuccess) { fprintf(stderr, "kernel_launch: hipFuncSetAttribute failed\n"); grid = -1; return; }
        int per_cu = 0;
        if (hipOccupancyMaxActiveBlocksPerMultiprocessor(&per_cu, (const void*)mk_fwd, 512, LDS_BYTES) != hipSuccess || per_cu < 1) fprintf(stderr, "kernel_launch: occupancy query says %d blocks/CU\n", per_cu);
        (void)hipGetLastError();
        grid = cus > 256 ? 256 : cus;
    }
    if (grid < 0) return;
    (void)hipMemsetAsync((char*)d_ws + WS_CTL, 0, CTL_ZERO_BYTES, stream);
    Args a{};
    for (int i = 0; i < 28; ++i) a.in[i] = (const float*)d_in[i];
    a.out = (float*)d_out; a.ws = (unsigned char*)d_ws;
#if MK_N_LAUNCHES == 1
    a.ph_lo = 0; a.ph_hi = NPHASE;
    hipLaunchKernelGGL(mk_fwd, dim3(grid), dim3(512), LDS_BYTES, stream, a);
#else
    for (int p = 0; p < NPHASE; ++p) { a.ph_lo = p; a.ph_hi = p + 1; hipLaunchKernelGGL(mk_fwd, dim3(grid), dim3(512), LDS_BYTES, stream, a); }
#endif
}
```

```cpp
#include <hip/hip_runtime.h>
#include <cstdio>
#include <cstdint>

#ifndef NSPLIT
#define NSPLIT 8
#endif
#ifndef PG8_SP2
#define PG8_SP2 1
#endif
#ifndef DUP_CONV
#define DUP_CONV 0
#endif
#ifndef MK_N_LAUNCHES
#define MK_N_LAUNCHES 1
#endif

constexpr int MP = 16384, MS = 1024, M = MP + MS;
constexpr int D = 1024, FF = 2816, NIN = 6144, NG = 64, NP = 64;
constexpr int SEQ = 4096, DSEQ = 32, NB = 4, NDB = 32;
constexpr float RMS_EPS = 1e-6f;
constexpr size_t O_Y = 0, O_CONVP = (size_t)M * D, O_SREP = O_CONVP + 8192, O_SIMP = O_SREP + 16384, O_CONVS = O_SIMP + 16384, O_SRES = O_CONVS + 65536, O_SIMS = O_SRES + 131072;

#define GAS __attribute__((address_space(1)))
#define LAS __attribute__((address_space(3)))
typedef unsigned short bf16_t;
typedef short bf16x8 __attribute__((ext_vector_type(8)));
typedef float f32x4 __attribute__((ext_vector_type(4)));
typedef float f32x2 __attribute__((ext_vector_type(2)));
typedef unsigned u32x4 __attribute__((ext_vector_type(4)));
typedef unsigned u32x2 __attribute__((ext_vector_type(2)));

__device__ __forceinline__ unsigned cvt_pk_bf16(float lo, float hi) { unsigned r; asm volatile("v_cvt_pk_bf16_f32 %0, %1, %2" : "=v"(r) : "v"(lo), "v"(hi)); return r; }
__device__ __forceinline__ float bf_lo(unsigned w) { return __uint_as_float(w << 16); }
__device__ __forceinline__ float bf_hi(unsigned w) { return __uint_as_float(w & 0xffff0000u); }
__device__ __forceinline__ float sigmoid_f(float v) { return __builtin_amdgcn_rcpf(1.0f + __builtin_amdgcn_exp2f(-1.4426950409f * v)); }
__device__ __forceinline__ float silu_f(float v) { return v * sigmoid_f(v); }
__device__ __forceinline__ void sigmoid8(const f32x4& x0, const f32x4& x1, float scale, f32x4& r0, f32x4& r1) {
    const f32x4 a0 = x0 * scale, a1 = x1 * scale; f32x4 e0, e1;
#pragma unroll
    for (int j = 0; j < 4; ++j) { e0[j] = __builtin_amdgcn_exp2f(a0[j]); e1[j] = __builtin_amdgcn_exp2f(a1[j]); }
    e0 = e0 + 1.0f; e1 = e1 + 1.0f;
#pragma unroll
    for (int j = 0; j < 4; ++j) { r0[j] = __builtin_amdgcn_rcpf(e0[j]); r1[j] = __builtin_amdgcn_rcpf(e1[j]); }
}
__device__ __forceinline__ float gelu_tanh_f(float v) { return v * sigmoid_f(1.5957691216f * (v + 0.044715f * v * v * v)); }

__device__ __forceinline__ void st16_wt(void* p, u32x4 v) { asm volatile("global_store_dwordx4 %0, %1, off sc1\n\ts_nop 1" :: "v"(p), "v"(v) : "memory"); }
#ifdef WT_STORES
__device__ __forceinline__ void st16(void* p, u32x4 v) { asm volatile("global_store_dwordx4 %0, %1, off sc1\n\ts_nop 1" :: "v"(p), "v"(v) : "memory"); }
__device__ __forceinline__ void st8(void* p, u32x2 v) { asm volatile("global_store_dwordx2 %0, %1, off sc1\n\ts_nop 1" :: "v"(p), "v"(v) : "memory"); }
#else
__device__ __forceinline__ void st16(void* p, u32x4 v) { *(u32x4*)p = v; }
__device__ __forceinline__ void st8(void* p, u32x2 v) { *(u32x2*)p = v; }
#endif

__device__ __forceinline__ u32x2 pack_unorm8(const float (&o)[8]) {
    u32x2 w = {0u, 0u};
#pragma unroll
    for (int j = 0; j < 4; ++j) { w.x = __builtin_amdgcn_cvt_pk_u8_f32(fmaf(o[j], 255.0f, 0.5f), j, w.x); w.y = __builtin_amdgcn_cvt_pk_u8_f32(fmaf(o[4 + j], 255.0f, 0.5f), j, w.y); }
    return w;
}
__device__ __forceinline__ float unorm8(unsigned w, int j) { return (float)((w >> (8 * j)) & 0xffu) * (1.0f / 255.0f); }

constexpr int RING_BYTES = 131072;
constexpr int SCR_OFF = RING_BYTES;
constexpr int LDS_BYTES = 163840;
constexpr int LDSCTL_OFF = LDS_BYTES - 512;
constexpr int SSB_OFF = SCR_OFF + 8192;

namespace pg8 {
constexpr int BM = 256, BK = 64, HALF = 128, HTB = HALF * BK * 2, NXCD = 8, WGM = 8;
__host__ __device__ __forceinline__ int lds_byte(int r, int c) { const int st = (r >> 4) * 2 + (c >> 5), rr = r & 15, cc = c & 31, ob = rr * 64 + cc * 2; return st * 1024 + (ob ^ (((ob >> 9) & 1) << 5)); }
__host__ __device__ __forceinline__ void stage_rc(int b, int& R, int& C) { const int st = b / 1024, sb = b % 1024, swz = sb ^ (((sb >> 9) & 1) << 5); R = (st >> 1) * 16 + swz / 64; C = (st & 1) * 32 + (swz % 64) / 2; }
__host__ __device__ __forceinline__ int perm32(int rho) { const int n = rho >> 4, i = rho & 15; return 8 * (i >> 2) + 4 * n + (i & 3); }

struct Unit { int pm, pn, kt0, nkt, part, tidx; };
struct Gemm { const bf16_t* A; const bf16_t* Bt; int M, N, K; unsigned a_rs, a_gs; };

struct StaticOrder {
    int nM, nN, nwg, G, c, nkt, ns, q, r, mp;
    __host__ __device__ __forceinline__ void init(int M_, int N_, int K_, int G_, int c_, int ns_) { nM = M_ / BM; nN = N_ / BM; nwg = nM * nN; G = G_; c = c_; nkt = K_ / BK; ns = ns_; q = nwg / G; r = nwg - q * G; mp = nM; if (ns != 8 || r == 0 || r * ns > G || nkt < 16) ns = 1; }
    __host__ __device__ __forceinline__ bool init_tailpanels(int M_, int N_, int K_, int G_, int c_, int tp) { nM = M_ / BM; nN = N_ / BM; nwg = nM * nN; G = G_; c = c_; nkt = K_ / BK; ns = 8; mp = nM - tp;
        q = (mp * nN) / G; r = tp * nN; return (mp * nN == q * G) && (r * ns <= G) && nkt >= 16; }
    __host__ __device__ __forceinline__ void tile(int L, Unit& u) const {
        const int nm = mp, nw = mp * nN;
        if (L >= nw) { const int j = L - nw; u.pm = mp + j / nN; u.pn = j % nN; return; }
        int wgid = L; { const int qq = nw / NXCD, rr = nw % NXCD, xcd = wgid % NXCD, off = wgid / NXCD; wgid = (xcd < rr ? xcd * (qq + 1) : rr * (qq + 1) + (xcd - rr) * qq) + off; }
        const int nig = WGM * nN, gid = wgid / nig, fm = gid * WGM, gsz = (nm - fm) < WGM ? (nm - fm) : WGM;
        u.pm = fm + ((wgid % nig) % gsz); u.pn = (wgid % nig) / gsz;
    }
    __device__ __forceinline__ void after_unit(int, int) const {}
    __host__ __device__ __forceinline__ bool next(int i, Unit& u) const {
        u.kt0 = 0; u.nkt = nkt; u.part = -1; u.tidx = 0;
        if (ns > 1) {
            const bool has_tail = c < r * ns;
            if (has_tail && i == 0) { if (ns == 8 && (r & 7) == 0) { const int k = c >> 3; u.tidx = (c & 7) + 8 * (k >> 3); u.part = k & 7; } else { u.tidx = c / ns; u.part = c % ns; }
                tile(q * G + u.tidx, u);
                const int pairs = nkt / 2, p0 = u.part * pairs / ns, p1 = (u.part + 1) * pairs / ns; u.kt0 = 2 * p0; u.nkt = 2 * (p1 - p0); return true; }
            const int j = has_tail ? i - 1 : i; if (j >= q) return false;
            tile(j * G + c, u); return true; }
        const long L = (long)i * G + c; if (L >= nwg) return false;
        tile((int)L, u); return true;
    }
};

constexpr int ZF_N1 = 12;
struct ZFirstOrder {
    StaticOrder A, B; int nA, nB, G, c, nkt, last_a; unsigned* done; unsigned* zx; unsigned xcd; volatile LAS unsigned* xst;
    __device__ __forceinline__ void init(int G_, int c_, unsigned* done_, unsigned* zx_, unsigned xcd_, volatile LAS unsigned* xst_) { G = G_; c = c_; done = done_; zx = zx_; xcd = xcd_; xst = xst_; A.init(M, ZF_N1 * BM, D, G_, c_, 1); B.init(M, (NIN / BM - ZF_N1) * BM, D, G_, c_, 1); nA = A.nwg; nB = B.nwg; nkt = D / BK;
        last_a = (c < nA) ? (nA - 1 - c) / G : -1; }
    __device__ __forceinline__ bool next(int i, Unit& u) const {
        u.kt0 = 0; u.nkt = nkt; u.part = -1; u.tidx = 0; const int L = i * G + c;
        if (L < nA) { A.tile(L, u); return true; }
        if (L < nA + nB) { B.tile(L - nA, u); u.pn += ZF_N1; return true; }
        return false;
    }
    __device__ __forceinline__ void after_unit(int ui, int tid) const {
        if (ui != last_a) return;
        asm volatile("s_waitcnt vmcnt(0)" ::: "memory"); __syncthreads();
        if (tid == 0) {
            const unsigned nl = (xst != nullptr && nA >= G) ? xst[0] : 0u;
            if (nl == 0u) { __builtin_amdgcn_fence(__ATOMIC_RELEASE, "agent"); asm volatile("s_waitcnt vmcnt(0)" ::: "memory"); __hip_atomic_fetch_add(done, 1u, __ATOMIC_RELAXED, __HIP_MEMORY_SCOPE_AGENT); }
            else { const unsigned old_ = __hip_atomic_fetch_add(zx + 64 * xcd, 1u, __ATOMIC_RELAXED, __HIP_MEMORY_SCOPE_AGENT);
                if (old_ + 1u == nl) { __builtin_amdgcn_fence(__ATOMIC_RELEASE, "agent"); asm volatile("s_waitcnt vmcnt(0)" ::: "memory"); __hip_atomic_fetch_add(done, nl, __ATOMIC_RELAXED, __HIP_MEMORY_SCOPE_AGENT); } } }
    }
    __device__ __forceinline__ int publishers() const { return nA < G ? nA : G; }
    __device__ __forceinline__ bool has_last_round_unit() const { return ((nA + nB - 1) / G) * G + c < nA + nB; }
};

typedef f32x4 Acc[2][2][4][2];

__device__ __forceinline__ float rrms_of(const float* ss, int row) { const f32x4 p = *(const f32x4*)(ss + (size_t)row * 4); return rsqrtf(((p[0] + p[1]) + (p[2] + p[3])) * (1.0f / D) + RMS_EPS); }

typedef f32x4 Slice[2][2];
struct EpiSwiGLU {
    static constexpr bool PERM = true, IDEM = true, RSCALE = true, FINAL = false; static constexpr int BATCH = 1, KINDS = 1;
    bf16_t* H; const float* ss;
    struct In {};
    __device__ __forceinline__ In load(const Unit&, int, int, int, int, int, int) const { return In{}; }
    __device__ __forceinline__ void rows(const Slice& v, const In& in, const Unit& u, int ai, int m, int wr, int wc, int fr, int fq, LAS float* scr) const { rows_s(v, in, u, ai, m, wr, wc, fr, fq, scr[ai * HALF + wr * 64 + m * 16 + fr]); }
    __device__ __forceinline__ void rows_s(const Slice& v, const In&, const Unit& u, int ai, int m, int wr, int wc, int fr, int fq, float s) const {
        const int rt = ai * HALF + wr * 64 + m * 16 + fr, row = u.pm * BM + rt, col0 = u.pn * HALF + wc * 32 + 8 * fq; const float s2 = s * s, sl = -1.4426950409f * s;
        f32x4 r0, r1; sigmoid8(v[0][0], v[0][1], sl, r0, r1);
        const f32x4 o0 = (v[0][0] * v[1][0]) * (r0 * s2), o1 = (v[0][1] * v[1][1]) * (r1 * s2);
        u32x4 w; w.x = cvt_pk_bf16(o0[0], o0[1]); w.y = cvt_pk_bf16(o0[2], o0[3]); w.z = cvt_pk_bf16(o1[0], o1[1]); w.w = cvt_pk_bf16(o1[2], o1[3]);
        st16(H + (size_t)row * FF + col0, w);
    }
    __device__ __forceinline__ void finish(const Unit&, LAS unsigned char*, int, int) const {}
};

template <bool BASE_BF16, bool OUT_F32, bool OUT_BF16>
struct EpiResid {
    static constexpr bool PERM = true, IDEM = true, RSCALE = false, FINAL = false; static constexpr int BATCH = 8, KINDS = 1;
    const float* base_p; const float* base_s; const bf16_t* base_b; float* out; bf16_t* xb; float* ss; float alpha;
    struct In { f32x4 b[2][2]; u32x4 w[2]; };
    __device__ __forceinline__ In load(const Unit& u, int ai, int m, int wr, int wc, int fr, int fq) const {
        const int row = u.pm * BM + ai * HALF + wr * 64 + m * 16 + fr, col0 = u.pn * BM + wc * 32 + 8 * fq; const size_t off = (size_t)row * D + col0;
        const float* base = (u.pm < MP / BM) ? base_p : (base_s - (size_t)MP * D); In in;
#pragma unroll
        for (int bj = 0; bj < 2; ++bj) {
            if (BASE_BF16) in.w[bj] = *(const u32x4*)(base_b + off + bj * HALF);
            else { in.b[bj][0] = *(const f32x4*)(base + off + bj * HALF); in.b[bj][1] = *(const f32x4*)(base + off + bj * HALF + 4); } }
        return in;
    }
    __device__ __forceinline__ void rows(const Slice& v, const In& in, const Unit& u, int ai, int m, int wr, int wc, int fr, int fq, LAS float* scr) const {
        const int rt = ai * HALF + wr * 64 + m * 16 + fr, row = u.pm * BM + rt, col0 = u.pn * BM + wc * 32 + 8 * fq;
        const size_t off = (size_t)row * D + col0; float sq = 0.f;
#pragma unroll
        for (int bj = 0; bj < 2; ++bj) { f32x4 b0, b1;
            if (BASE_BF16) { const u32x4 w = in.w[bj]; b0 = (f32x4){bf_lo(w.x), bf_hi(w.x), bf_lo(w.y), bf_hi(w.y)}; b1 = (f32x4){bf_lo(w.z), bf_hi(w.z), bf_lo(w.w), bf_hi(w.w)}; } else { b0 = in.b[bj][0]; b1 = in.b[bj][1]; }
            const f32x4 x0 = b0 + alpha * v[bj][0], x1 = b1 + alpha * v[bj][1];
            if (OUT_F32) { *(f32x4*)(out + off + bj * HALF) = x0; *(f32x4*)(out + off + bj * HALF + 4) = x1; }
            sq += ((x0[0] * x0[0] + x0[1] * x0[1]) + (x0[2] * x0[2] + x0[3] * x0[3])) + ((x1[0] * x1[0] + x1[1] * x1[1]) + (x1[2] * x1[2] + x1[3] * x1[3]));
            if (OUT_BF16) { u32x4 w; w.x = cvt_pk_bf16(x0[0], x0[1]); w.y = cvt_pk_bf16(x0[2], x0[3]); w.z = cvt_pk_bf16(x1[0], x1[1]); w.w = cvt_pk_bf16(x1[2], x1[3]); st16(xb + off + bj * HALF, w); } }
        sq += __shfl_xor(sq, 16); sq += __shfl_xor(sq, 32);
        if (fq == 0) scr[rt * 4 + wc] = sq;
    }
    __device__ __forceinline__ void finish(const Unit& u, LAS unsigned char* lds, int tid, int sel) const {
        LAS float* scr = (LAS float*)(lds + SCR_OFF);
        asm volatile("s_waitcnt lgkmcnt(0)" ::: "memory"); __builtin_amdgcn_s_barrier(); asm volatile("" ::: "memory");
        if (tid < 256 && (sel < 0 || (((tid >> 7) * 4 + ((tid >> 4) & 3)) == sel))) { const f32x4 p = *(const LAS f32x4*)(scr + tid * 4); ss[(size_t)(u.pm * BM + tid) * 4 + u.pn] = (p[0] + p[1]) + (p[2] + p[3]); }
    }
};

struct EpiMixIn {
    static constexpr bool PERM = true, IDEM = true, RSCALE = true, FINAL = false; static constexpr int BATCH = 1, KINDS = 5;
    bf16_t *Z, *BG, *U; unsigned char *SG8C, *SG8S; const float* ss; float* dout;
    struct In {};
    __device__ __forceinline__ In load(const Unit&, int, int, int, int, int, int) const { return In{}; }
    __device__ __forceinline__ int kind(const Unit& u) const { const int pn = u.pn; if (pn >= 16) return 3; if (pn >= 12) return 2; if (pn >= 8) return 1; return (u.pm >= MP / BM || (u.pm & (SEQ / BM - 1)) == SEQ / BM - 1) ? 4 : 0; }
    template <int KIND>
    __device__ __forceinline__ void rows_k(const Slice& v, const In&, const Unit& u, int ai, int m, int wr, int wc, int fr, int fq, float s) const {
        const int rt = ai * HALF + wr * 64 + m * 16 + fr, row = u.pm * BM + rt; const int pn = u.pn;
        if constexpr (KIND == 0 || KIND == 4) {
            const int col = pn * HALF + wc * 32 + 8 * fq; const float s2 = s * s;
            const f32x4 o0 = (v[0][0] * v[1][0]) * s2, o1 = (v[0][1] * v[1][1]) * s2;
            u32x4 w; w.x = cvt_pk_bf16(o0[0], o0[1]); w.y = cvt_pk_bf16(o0[2], o0[3]); w.z = cvt_pk_bf16(o1[0], o1[1]); w.w = cvt_pk_bf16(o1[2], o1[3]);
            st16(Z + (size_t)row * D + col, w);
            if constexpr (KIND == 4) { int t, seq; float* cs;
                if (row < MP) { seq = row >> 12; t = (row & 4095) - (SEQ - 2); cs = dout + O_CONVP; } else { const int r2 = row - MP; seq = r2 >> 5; t = (r2 & 31) - (DSEQ - 2); cs = dout + O_CONVS; }
                if (t >= 0) { float* p = cs + ((size_t)seq * 2 + t) * D + col; *(f32x4*)p = o0; *(f32x4*)(p + 4) = o1; } }
        } else {
#pragma unroll
            for (int bj = 0; bj < 2; ++bj) { const int cc = (pn & 3) * BM + bj * HALF + wc * 32 + 8 * fq;
                if constexpr (KIND == 3) { f32x4 r0, r1; sigmoid8(v[bj][0], v[bj][1], -1.4426950409f * s, r0, r1); float o[8];
#pragma unroll
                    for (int j = 0; j < 4; ++j) { o[j] = r0[j]; o[4 + j] = r1[j]; }
                    const u32x2 g8 = pack_unorm8(o); st8((pn < 20 ? SG8C : SG8S) + (size_t)row * D + cc, g8); }
                else { const f32x4 o0 = v[bj][0] * s, o1 = v[bj][1] * s;
                    u32x4 w; w.x = cvt_pk_bf16(o0[0], o0[1]); w.y = cvt_pk_bf16(o0[2], o0[3]); w.z = cvt_pk_bf16(o1[0], o1[1]); w.w = cvt_pk_bf16(o1[2], o1[3]);
                    if constexpr (KIND == 1) st16(BG + (size_t)row * D + cc, w);
                    else st16(U + ((size_t)(cc >> 4) * M + row) * 16 + (cc & 15), w); } }
        }
    }
    __device__ __forceinline__ void rows(const Slice& v, const In& in, const Unit& u, int ai, int m, int wr, int wc, int fr, int fq, LAS float* scr) const {
        const float s = scr[ai * HALF + wr * 64 + m * 16 + fr];
        switch (kind(u)) { case 0: rows_k<0>(v, in, u, ai, m, wr, wc, fr, fq, s); break; case 1: rows_k<1>(v, in, u, ai, m, wr, wc, fr, fq, s); break; case 2: rows_k<2>(v, in, u, ai, m, wr, wc, fr, fq, s); break;
            case 3: rows_k<3>(v, in, u, ai, m, wr, wc, fr, fq, s); break; default: rows_k<4>(v, in, u, ai, m, wr, wc, fr, fq, s); break; }
    }
    __device__ __forceinline__ void finish(const Unit&, LAS unsigned char*, int, int) const {}
};

struct EpiConvOut {
    static constexpr bool PERM = true, IDEM = true, RSCALE = false, FINAL = false; static constexpr int BATCH = 8, KINDS = 1;
    const unsigned char* G8; bf16_t* T;
    struct In { u32x2 g[2]; };
    __device__ __forceinline__ In load(const Unit& u, int ai, int m, int wr, int wc, int fr, int fq) const {
        const int row = u.pm * BM + ai * HALF + wr * 64 + m * 16 + fr, col0 = u.pn * BM + wc * 32 + 8 * fq; In in;
#pragma unroll
        for (int bj = 0; bj < 2; ++bj) in.g[bj] = *(const u32x2*)(G8 + (size_t)row * D + col0 + bj * HALF);
        return in;
    }
    __device__ __forceinline__ void rows(const Slice& v, const In& in, const Unit& u, int ai, int m, int wr, int wc, int fr, int fq, LAS float*) const {
        const int row = u.pm * BM + ai * HALF + wr * 64 + m * 16 + fr, col0 = u.pn * BM + wc * 32 + 8 * fq;
#pragma unroll
        for (int bj = 0; bj < 2; ++bj) { const u32x2 g = in.g[bj]; u32x4 w;
            w.x = cvt_pk_bf16(unorm8(g.x, 0) * v[bj][0][0], unorm8(g.x, 1) * v[bj][0][1]); w.y = cvt_pk_bf16(unorm8(g.x, 2) * v[bj][0][2], unorm8(g.x, 3) * v[bj][0][3]);
            w.z = cvt_pk_bf16(unorm8(g.y, 0) * v[bj][1][0], unorm8(g.y, 1) * v[bj][1][1]); w.w = cvt_pk_bf16(unorm8(g.y, 2) * v[bj][1][2], unorm8(g.y, 3) * v[bj][1][3]);
            st16(T + (size_t)row * D + col0 + bj * HALF, w); }
    }
    __device__ __forceinline__ void finish(const Unit&, LAS unsigned char*, int, int) const {}
};

struct EpiGlu {
    static constexpr bool PERM = true, IDEM = true, RSCALE = false, FINAL = false; static constexpr int BATCH = 8, KINDS = 1;
    const bf16_t* T0; const unsigned char* SG8; bf16_t* MG;
    struct In { u32x4 t; u32x2 g; };
    __device__ __forceinline__ In load(const Unit& u, int ai, int m, int wr, int wc, int fr, int fq) const {
        const int row = u.pm * BM + ai * HALF + wr * 64 + m * 16 + fr, col0 = u.pn * HALF + wc * 32 + 8 * fq; const size_t off = (size_t)row * D + col0;
        In in; in.t = *(const u32x4*)(T0 + off); in.g = *(const u32x2*)(SG8 + off); return in;
    }
    __device__ __forceinline__ void rows(const Slice& v, const In& in, const Unit& u, int ai, int m, int wr, int wc, int fr, int fq, LAS float*) const {
        const int row = u.pm * BM + ai * HALF + wr * 64 + m * 16 + fr, col0 = u.pn * HALF + wc * 32 + 8 * fq; const size_t off = (size_t)row * D + col0;
        const u32x4 t = in.t; const u32x2 g = in.g; float o[8];
        const float tv[8] = {bf_lo(t.x), bf_hi(t.x), bf_lo(t.y), bf_hi(t.y), bf_lo(t.z), bf_hi(t.z), bf_lo(t.w), bf_hi(t.w)};
        const float gv[8] = {unorm8(g.x, 0), unorm8(g.x, 1), unorm8(g.x, 2), unorm8(g.x, 3), unorm8(g.y, 0), unorm8(g.y, 1), unorm8(g.y, 2), unorm8(g.y, 3)};
        f32x4 r0, r1; sigmoid8(v[1][0], v[1][1], -1.4426950409f, r0, r1);
#pragma unroll
        for (int j = 0; j < 4; ++j) { o[j] = tv[j] + gv[j] * v[0][0][j] * r0[j]; o[4 + j] = tv[4 + j] + gv[4 + j] * v[0][1][j] * r1[j]; }
        u32x4 w; w.x = cvt_pk_bf16(o[0], o[1]); w.y = cvt_pk_bf16(o[2], o[3]); w.z = cvt_pk_bf16(o[4], o[5]); w.w = cvt_pk_bf16(o[6], o[7]);
        st16(MG + off, w);
    }
    __device__ __forceinline__ void finish(const Unit&, LAS unsigned char*, int, int) const {}
};

struct EpiFinal {
    static constexpr bool PERM = true, IDEM = false, RSCALE = false, FINAL = true;
    const bf16_t* base_b; float* Y; float* xs; unsigned* cnt; unsigned* cnt2; const float* g; float alpha;
    struct In { u32x4 w[2]; };
    struct Gv { f32x4 g[2][2]; };
    __device__ __forceinline__ In load(const Unit& u, int ai, int m, int wr, int wc, int fr, int fq) const {
        const int row = u.pm * BM + ai * HALF + wr * 64 + m * 16 + fr, col0 = u.pn * BM + wc * 32 + 8 * fq; const size_t off = (size_t)row * D + col0; In in;
#pragma unroll
        for (int bj = 0; bj < 2; ++bj) in.w[bj] = *(const u32x4*)(base_b + off + bj * HALF);
        return in;
    }
    __device__ __forceinline__ Gv load_g(const Unit& u, int wc, int fq) const { const int col0 = u.pn * BM + wc * 32 + 8 * fq; Gv r;
#pragma unroll
        for (int bj = 0; bj < 2; ++bj)
#pragma unroll
            for (int n = 0; n < 2; ++n) r.g[bj][n] = *(const f32x4*)(g + col0 + bj * HALF + n * 4);
        return r; }
    __device__ __forceinline__ void pass1(Slice& v, const In& in, const Unit& u, int ai, int m, int wr, int wc, int fr, int fq, LAS float* scr) const {
        const int rt = ai * HALF + wr * 64 + m * 16 + fr; float sq = 0.f;
#pragma unroll
        for (int bj = 0; bj < 2; ++bj) { const u32x4 w = in.w[bj];
#pragma unroll
            for (int n = 0; n < 2; ++n) { const unsigned w0 = n ? w.z : w.x, w1 = n ? w.w : w.y; const f32x4 b = {bf_lo(w0), bf_hi(w0), bf_lo(w1), bf_hi(w1)};
                const f32x4 x = b + alpha * v[bj][n]; v[bj][n] = x; sq += (x[0] * x[0] + x[1] * x[1]) + (x[2] * x[2] + x[3] * x[3]); } }
        sq += __shfl_xor(sq, 16); sq += __shfl_xor(sq, 32);
        if (fq == 0) scr[rt * 4 + wc] = sq;
    }
    __device__ __forceinline__ void exchange(const Unit& u, int sel, LAS unsigned char* lds, int tid) const {
        LAS float* scr = (LAS float*)(lds + SCR_OFF); const int wid = __builtin_amdgcn_readfirstlane(tid >> 6), lane = tid & 63;
        const bool mine = tid < 256 && (sel < 0 || (((tid >> 7) * 4 + ((tid >> 4) & 3)) == sel));
        unsigned* c = sel < 0 ? cnt + 64 * u.pm : cnt2 + 64 * ((u.pm - MP / BM) * 8 + sel);
        asm volatile("s_waitcnt lgkmcnt(0)" ::: "memory"); __builtin_amdgcn_s_barrier(); asm volatile("" ::: "memory");
        if (mine) { const f32x4 p = *(const LAS f32x4*)(scr + tid * 4); __hip_atomic_store((unsigned*)(xs + (size_t)(u.pm * BM + tid) * 4 + u.pn), __float_as_uint((p[0] + p[1]) + (p[2] + p[3])), __ATOMIC_RELAXED, __HIP_MEMORY_SCOPE_AGENT); }
        asm volatile("s_waitcnt vmcnt(0)" ::: "memory");
        if (lane == 0) __hip_atomic_fetch_add(c, 1u, __ATOMIC_RELAXED, __HIP_MEMORY_SCOPE_AGENT);
        if (wid == 0) { unsigned sp = 0; while ((unsigned)__builtin_amdgcn_readfirstlane(__hip_atomic_load(c, __ATOMIC_RELAXED, __HIP_MEMORY_SCOPE_AGENT)) < 32u) { __builtin_amdgcn_s_sleep(2); if (++sp > (1u << 22)) break; } }
        asm volatile("s_waitcnt vmcnt(0) lgkmcnt(0)" ::: "memory"); __builtin_amdgcn_s_barrier(); asm volatile("" ::: "memory");
        if (mine) { const unsigned* sl = (const unsigned*)(xs + (size_t)(u.pm * BM + tid) * 4); float t = 0.f;
#pragma unroll
            for (int k = 0; k < 4; ++k) t += __uint_as_float(__hip_atomic_load(sl + k, __ATOMIC_RELAXED, __HIP_MEMORY_SCOPE_AGENT));
            scr[1024 + tid] = rsqrtf(t * (1.0f / D) + RMS_EPS); }
        asm volatile("s_waitcnt lgkmcnt(0)" ::: "memory"); __builtin_amdgcn_s_barrier(); asm volatile("" ::: "memory");
    }
    __device__ __forceinline__ void pass2(const Slice& v, const Gv& gv, const Unit& u, int ai, int m, int wr, int wc, int fr, int fq, const LAS float* scr) const {
        const int rt = ai * HALF + wr * 64 + m * 16 + fr, row = u.pm * BM + rt, col0 = u.pn * BM + wc * 32 + 8 * fq; const size_t off = (size_t)row * D + col0; const float s = scr[1024 + rt];
#pragma unroll
        for (int bj = 0; bj < 2; ++bj)
#pragma unroll
            for (int n = 0; n < 2; ++n) *(f32x4*)(Y + off + bj * HALF + n * 4) = v[bj][n] * s * gv.g[bj][n];
    }
};

__device__ __forceinline__ void stage_ss(const float* ss, int pm, int par, LAS unsigned char* lds, int tid) {
    const int wid = __builtin_amdgcn_readfirstlane(tid >> 6);
    __builtin_amdgcn_global_load_lds((const unsigned*)(ss + (size_t)(pm * BM + (tid & 255)) * 4), (LAS unsigned*)(lds + SSB_OFF + par * 4096 + (wid & 3) * 1024), 16, 0, 0);
}
template <class Epi>
__device__ __forceinline__ void run_epilogue(const Epi& E, const Acc& acc, const Unit& u, int wr, int wc, int fr, int fq, LAS unsigned char* lds, int tid, int par, bool has_next, int next_pm) {
    asm volatile("" : "+v"(fr), "+v"(fq));
    LAS float* scr = (LAS float*)(lds + SCR_OFF);
    LAS float* tab = scr + 1024 + par * 256;
    if constexpr (Epi::RSCALE) { if (has_next) stage_ss(E.ss, next_pm, par ^ 1, lds, tid); }
    constexpr int NB = Epi::BATCH;
    float sc[8];
    if constexpr (Epi::RSCALE) {
#pragma unroll
        for (int h = 0; h < 2; ++h) { f32x4 pp[4];
#pragma unroll
            for (int k = 0; k < 4; ++k) pp[k] = *(const LAS f32x4*)(lds + SSB_OFF + par * 4096 + (h * HALF + wr * 64 + k * 16 + fr) * 16);
            asm volatile("s_waitcnt lgkmcnt(0)" ::: "memory");
#pragma unroll
            for (int k = 0; k < 4; ++k) sc[h * 4 + k] = __builtin_amdgcn_rsqf(((pp[k][0] + pp[k][1]) + (pp[k][2] + pp[k][3])) * (1.0f / D) + RMS_EPS); } }
    if constexpr (Epi::KINDS > 1) {
        const int kd = E.kind(u);
#define PG8_KIND_BODY(KD) { _Pragma("unroll") for (int k = 0; k < 8; ++k) { const int ai = k >> 2, m = k & 3; \
            const Slice v = {{acc[ai][0][m][0], acc[ai][0][m][1]}, {acc[ai][1][m][0], acc[ai][1][m][1]}}; E.template rows_k<KD>(v, typename Epi::In{}, u, ai, m, wr, wc, fr, fq, sc[k]); } }
        if (kd == 0) PG8_KIND_BODY(0) else if (kd == 1) PG8_KIND_BODY(1) else if (kd == 2) PG8_KIND_BODY(2) else if (kd == 3) PG8_KIND_BODY(3) else PG8_KIND_BODY(4)
#undef PG8_KIND_BODY
    } else {
#pragma unroll
    for (int k0 = 0; k0 < 8; k0 += NB) { typename Epi::In in[NB];
#pragma unroll
        for (int k = 0; k < NB; ++k) in[k] = E.load(u, (k0 + k) >> 2, (k0 + k) & 3, wr, wc, fr, fq);
#pragma unroll
        for (int k = 0; k < NB; ++k) { const int ai = (k0 + k) >> 2, m = (k0 + k) & 3;
            const Slice v = {{acc[ai][0][m][0], acc[ai][0][m][1]}, {acc[ai][1][m][0], acc[ai][1][m][1]}};
            if constexpr (Epi::RSCALE) E.rows_s(v, in[k], u, ai, m, wr, wc, fr, fq, sc[k0 + k]); else E.rows(v, in[k], u, ai, m, wr, wc, fr, fq, scr); } }
    }
    E.finish(u, lds, tid, -1);
}
__device__ __forceinline__ void store_partial(u32x2* P, int ns, const Acc& acc, const Unit& u, int tid) {
    int tid_o = tid; asm volatile("" : "+v"(tid_o));
    u32x2* p = P + ((size_t)(u.tidx * ns + u.part) * 32) * 512 + tid_o;
#pragma unroll
    for (int ai = 0; ai < 2; ++ai)
#pragma unroll
        for (int bj = 0; bj < 2; ++bj)
#pragma unroll
            for (int m = 0; m < 4; ++m)
#pragma unroll
                for (int n = 0; n < 2; ++n) { const f32x4 v = acc[ai][bj][m][n]; u32x2 w; w.x = cvt_pk_bf16(v[0], v[1]); w.y = cvt_pk_bf16(v[2], v[3]);
                    asm volatile("global_store_dwordx2 %0, %1, off sc1\n\ts_nop 1" :: "v"(&p[(size_t)((((ai * 2 + bj) * 4 + m) * 2 + n)) * 512]), "v"(w) : "memory"); }
}
template <bool SPLIT, class Epi, class Ord>
__device__ __forceinline__ void gemm_phase(LAS unsigned char* lds, const Gemm g, const Ord& S, const Epi& E, u32x2* P, unsigned* cnt) {
    const int tid = threadIdx.x, wid = __builtin_amdgcn_readfirstlane(tid >> 6), lane = tid & 63, wr = wid >> 2, wc = wid & 3, fr = lane & 15, fq = lane >> 4;
    const int K = g.K;
    unsigned voffA, voffB;
    { int R, C; stage_rc(tid * 16, R, C); const int Rb = Epi::PERM ? ((R & ~31) + perm32(R & 31)) : R;
      voffA = (unsigned)R * g.a_rs + (unsigned)(C >> 4) * g.a_gs + (unsigned)(C & 15) * 2u; voffB = (unsigned)(Rb * K + C) * 2u; }
    const size_t dltA = (size_t)64 * g.a_rs, dltB = (size_t)64 * K * 2;
    const size_t kstepA = (size_t)4 * g.a_gs, hstepA = (size_t)HALF * g.a_rs, tstepA = 2 * hstepA;
    const size_t kstepB = (size_t)(BK * 2), hstepB = (size_t)HALF * K * 2, tstepB = 2 * hstepB;
    const unsigned ldsw = (unsigned)wid * 1024u;
    const int aoff = lds_byte(wr * 64 + fr, fq * 8), boff = lds_byte(wc * 32 + fr, fq * 8);
#define PG8_SA(b, h) (((b) * 2 + (h)) * HTB)
#define PG8_SB(b, h) ((4 + (b) * 2 + (h)) * HTB)
#define PG8_STAGE(bufoff, gbase, voff) do { _Pragma("unroll") for (int _i = 0; _i < 2; ++_i) \
        __builtin_amdgcn_global_load_lds((const unsigned*)((const char*)(gbase) + (size_t)_i * dlt_##voff + (voff)), (LAS unsigned*)(lds + (bufoff) + ldsw + _i * 8192), 16, 0, 0); } while (0)
#define dlt_voffA dltA
#define dlt_voffB dltB
#define PG8_LDA(dst, b, h) do { _Pragma("unroll") for (int m = 0; m < 4; ++m) _Pragma("unroll") for (int k = 0; k < 2; ++k) dst[m][k] = *(const LAS bf16x8*)(lds + PG8_SA(b, h) + aoff + m * 2048 + k * 1024); } while (0)
#define PG8_LDB(dst, b, h) do { _Pragma("unroll") for (int n = 0; n < 2; ++n) _Pragma("unroll") for (int k = 0; k < 2; ++k) dst[n][k] = *(const LAS bf16x8*)(lds + PG8_SB(b, h) + boff + n * 2048 + k * 1024); } while (0)
#define PG8_MMA(ai, bj, At, Bt) do { __builtin_amdgcn_s_setprio(1); _Pragma("unroll") for (int m = 0; m < 4; ++m) _Pragma("unroll") for (int n = 0; n < 2; ++n) _Pragma("unroll") for (int k = 0; k < 2; ++k) \
        acc[ai][bj][m][n] = __builtin_amdgcn_mfma_f32_16x16x32_bf16(Bt[n][k], At[m][k], acc[ai][bj][m][n], 0, 0, 0); __builtin_amdgcn_s_setprio(0); } while (0)
#define PG8_MMAZ(ai, bj, At, Bt) do { __builtin_amdgcn_s_setprio(1); _Pragma("unroll") for (int m = 0; m < 4; ++m) _Pragma("unroll") for (int n = 0; n < 2; ++n) { \
        acc[ai][bj][m][n] = __builtin_amdgcn_mfma_f32_16x16x32_bf16(Bt[n][0], At[m][0], (f32x4){0.f, 0.f, 0.f, 0.f}, 0, 0, 0); \
        acc[ai][bj][m][n] = __builtin_amdgcn_mfma_f32_16x16x32_bf16(Bt[n][1], At[m][1], acc[ai][bj][m][n], 0, 0, 0); } __builtin_amdgcn_s_setprio(0); } while (0)
#define PG8_WAIT_V(n) asm volatile("s_waitcnt vmcnt(" #n ")" ::: "memory")
#define PG8_WAIT_L(n) asm volatile("s_waitcnt lgkmcnt(" #n ")" ::: "memory")
#define PG8_BAR __builtin_amdgcn_s_barrier()
#define PG8_SCHED __builtin_amdgcn_sched_barrier(0)
    Unit cur, nxt; int ui = 0;
    if (!S.next(0, cur)) return;
    Acc acc;
    bf16x8 At[4][2], B0[2][2], B1[2][2];
    if constexpr (Epi::RSCALE) stage_ss(E.ss, cur.pm, 0, lds, tid);
    const char* cA = (const char*)g.A + (size_t)cur.pm * tstepA + (size_t)cur.kt0 * kstepA; const char* cB = (const char*)g.Bt + (size_t)cur.pn * tstepB + (size_t)cur.kt0 * kstepB;
#if PG8_SP2
    PG8_STAGE(PG8_SB(0, 0), cB, voffB); PG8_STAGE(PG8_SB(0, 1), cB + hstepB, voffB); PG8_STAGE(PG8_SA(0, 0), cA, voffA); PG8_STAGE(PG8_SA(0, 1), cA + hstepA, voffA);
    if (wr == 1) PG8_BAR;
    PG8_WAIT_V(2); PG8_BAR;
    PG8_STAGE(PG8_SB(1, 0), cB + kstepB, voffB); PG8_STAGE(PG8_SA(1, 0), cA + kstepA, voffA); PG8_STAGE(PG8_SB(1, 1), cB + hstepB + kstepB, voffB);
    PG8_WAIT_V(6); PG8_BAR;
#else
    PG8_STAGE(PG8_SB(0, 0), cB, voffB); PG8_STAGE(PG8_SA(0, 0), cA, voffA); PG8_STAGE(PG8_SB(0, 1), cB + hstepB, voffB); PG8_STAGE(PG8_SA(0, 1), cA + hstepA, voffA);
    if (wr == 1) PG8_BAR;
    PG8_WAIT_V(4); PG8_BAR;
    PG8_STAGE(PG8_SB(1, 0), cB + kstepB, voffB); PG8_STAGE(PG8_SA(1, 0), cA + kstepA, voffA); PG8_STAGE(PG8_SB(1, 1), cB + hstepB + kstepB, voffB);
    PG8_WAIT_V(6); PG8_BAR;
#endif
    for (;;) {
#ifdef KDUP
        const bool has_next = S.next((ui + 1) >> 1, nxt); const bool do_epi = (ui & 1) != 0;
#else
        const bool has_next = S.next(ui + 1, nxt); const bool do_epi = true;
#endif
        const char* nA = has_next ? (const char*)g.A + (size_t)nxt.pm * tstepA + (size_t)nxt.kt0 * kstepA : cA; const char* nB = has_next ? (const char*)g.Bt + (size_t)nxt.pn * tstepB + (size_t)nxt.kt0 * kstepB : cB;
        const int nt = cur.nkt;
#define PG8_ITER(t, MM) do { \
            const bool last = ((t) == nt - 2); \
            const char* a1 = cA + (size_t)((t) + 1) * kstepA; \
            const char* a2 = last ? nA : cA + (size_t)((t) + 2) * kstepA; const char* b2 = last ? nB : cB + (size_t)((t) + 2) * kstepB; \
            const char* a3 = a2 + kstepA; const char* b3 = b2 + kstepB; \
            PG8_LDB(B0, 0, 0); PG8_LDB(B1, 0, 1); PG8_SCHED; PG8_LDA(At, 0, 0); PG8_STAGE(PG8_SA(1, 1), a1 + hstepA, voffA); \
            PG8_WAIT_V(8); PG8_WAIT_L(0); PG8_BAR; MM(0, 0, At, B0); MM(0, 1, At, B1); PG8_BAR; PG8_SCHED; \
            PG8_LDA(At, 0, 1); PG8_STAGE(PG8_SB(0, 0), b2, voffB); PG8_STAGE(PG8_SB(0, 1), b2 + hstepB, voffB); PG8_STAGE(PG8_SA(0, 0), a2, voffA); \
            PG8_WAIT_V(8); PG8_WAIT_L(0); PG8_BAR; MM(1, 0, At, B0); MM(1, 1, At, B1); PG8_BAR; PG8_SCHED; \
            PG8_LDB(B0, 1, 0); PG8_LDB(B1, 1, 1); PG8_SCHED; PG8_LDA(At, 1, 0); PG8_STAGE(PG8_SA(0, 1), a2 + hstepA, voffA); \
            PG8_WAIT_V(8); PG8_WAIT_L(0); PG8_BAR; PG8_MMA(0, 0, At, B0); PG8_MMA(0, 1, At, B1); PG8_BAR; PG8_SCHED; \
            PG8_LDA(At, 1, 1); PG8_STAGE(PG8_SB(1, 0), b3, voffB); PG8_STAGE(PG8_SB(1, 1), b3 + hstepB, voffB); PG8_STAGE(PG8_SA(1, 0), a3, voffA); \
            PG8_WAIT_V(8); PG8_WAIT_L(0); PG8_BAR; PG8_MMA(1, 0, At, B0); PG8_MMA(1, 1, At, B1); PG8_BAR; PG8_SCHED; } while (0)
        PG8_ITER(0, PG8_MMAZ);
        for (int t = 2; t < nt; t += 2) PG8_ITER(t, PG8_MMA);
#undef PG8_ITER
        if (wr == 0) PG8_BAR;
#ifdef KDUP
        if (do_epi) { _Pragma("unroll") for (int a_ = 0; a_ < 2; ++a_) _Pragma("unroll") for (int b_ = 0; b_ < 2; ++b_) _Pragma("unroll") for (int m_ = 0; m_ < 4; ++m_) _Pragma("unroll") for (int n_ = 0; n_ < 2; ++n_) acc[a_][b_][m_][n_] *= 0.5f; }
#endif
        if (!do_epi) {}
#ifdef EDUP
        else if (!SPLIT || cur.part < 0) { static_assert(!Epi::FINAL, "EDUP probe predates the fused final epilogue"); run_epilogue(E, acc, cur, wr, wc, fr, fq, lds, tid, ui & 1, false, 0); if (Epi::IDEM) { asm volatile("" ::: "memory"); run_epilogue(E, acc, cur, wr, wc, fr, fq, lds, tid, ui & 1, has_next, nxt.pm); } }
#else
        else if (!SPLIT || cur.part < 0) {
            if constexpr (Epi::FINAL) { LAS float* scr = (LAS float*)(lds + SCR_OFF); int fr_ = fr, fq_ = fq; asm volatile("" : "+v"(fr_), "+v"(fq_));
                { typename Epi::In in[8];
#pragma unroll
                  for (int k = 0; k < 8; ++k) in[k] = E.load(cur, k >> 2, k & 3, wr, wc, fr_, fq_);
#pragma unroll
                  for (int k = 0; k < 8; ++k) { const int ai = k >> 2, m = k & 3; Slice v = {{acc[ai][0][m][0], acc[ai][0][m][1]}, {acc[ai][1][m][0], acc[ai][1][m][1]}}; E.pass1(v, in[k], cur, ai, m, wr, wc, fr_, fq_, scr);
                      acc[ai][0][m][0] = v[0][0]; acc[ai][0][m][1] = v[0][1]; acc[ai][1][m][0] = v[1][0]; acc[ai][1][m][1] = v[1][1]; } }
                const typename Epi::Gv gv = E.load_g(cur, wc, fq_);
                E.exchange(cur, -1, lds, tid);
#pragma unroll
                for (int ai = 0; ai < 2; ++ai)
#pragma unroll
                    for (int m = 0; m < 4; ++m) { const Slice v = {{acc[ai][0][m][0], acc[ai][0][m][1]}, {acc[ai][1][m][0], acc[ai][1][m][1]}}; E.pass2(v, gv, cur, ai, m, wr, wc, fr_, fq_, scr); }
            } else run_epilogue(E, acc, cur, wr, wc, fr, fq, lds, tid, ui & 1, has_next, nxt.pm);
            S.after_unit(ui, tid);
        }
#endif
        else {
            store_partial(P, 8, acc, cur, tid);
            asm volatile("s_waitcnt vmcnt(0)" ::: "memory"); __syncthreads();
            if (tid == 0) { unsigned* c = cnt + 64 * cur.tidx;
                __hip_atomic_fetch_add(c, 1u, __ATOMIC_RELAXED, __HIP_MEMORY_SCOPE_AGENT);
                unsigned sp = 0; while (__hip_atomic_load(c, __ATOMIC_RELAXED, __HIP_MEMORY_SCOPE_AGENT) < 8u) { __builtin_amdgcn_s_sleep(1); if (++sp > (1u << 22)) break; } }
            __syncthreads();
            const int sel = cur.part, sai = sel >> 2, sm = sel & 3; LAS float* scr = (LAS float*)(lds + SCR_OFF);
            Slice v = {{{0.f, 0.f, 0.f, 0.f}, {0.f, 0.f, 0.f, 0.f}}, {{0.f, 0.f, 0.f, 0.f}, {0.f, 0.f, 0.f, 0.f}}};
            { u32x2 t[8][2][2];
              int tid_o = tid; asm volatile("" : "+v"(tid_o));
#pragma unroll
              for (int pp = 0; pp < 8; ++pp) { const u32x2* p = P + ((size_t)(cur.tidx * 8 + pp) * 32) * 512 + tid_o;
#pragma unroll
                  for (int bj = 0; bj < 2; ++bj)
#pragma unroll
                      for (int n = 0; n < 2; ++n) { const unsigned long long q8 = __hip_atomic_load((const unsigned long long*)&p[(size_t)((((sai * 2 + bj) * 4 + sm) * 2 + n)) * 512], __ATOMIC_RELAXED, __HIP_MEMORY_SCOPE_AGENT);
                          t[pp][bj][n] = (u32x2){(unsigned)q8, (unsigned)(q8 >> 32)}; } }
#pragma unroll
              for (int pp = 0; pp < 8; ++pp)
#pragma unroll
                  for (int bj = 0; bj < 2; ++bj)
#pragma unroll
                      for (int n = 0; n < 2; ++n) { const u32x2 w = t[pp][bj][n]; v[bj][n] += (f32x4){bf_lo(w.x), bf_hi(w.x), bf_lo(w.y), bf_hi(w.y)}; } }
            Unit fu = cur; fu.part = -1;
            if constexpr (Epi::FINAL) { const typename Epi::In fin = E.load(fu, sai, sm, wr, wc, fr, fq); const typename Epi::Gv gv = E.load_g(fu, wc, fq); E.pass1(v, fin, fu, sai, sm, wr, wc, fr, fq, scr); E.exchange(fu, sel, lds, tid); E.pass2(v, gv, fu, sai, sm, wr, wc, fr, fq, scr); }
            else { const typename Epi::In fin = E.load(fu, sai, sm, wr, wc, fr, fq); E.rows(v, fin, fu, sai, sm, wr, wc, fr, fq, scr); E.finish(fu, lds, tid, sel); }
        }
        if (!has_next) break;
        cur = nxt; cA = nA; cB = nB; ++ui;
        if (wr == 1) PG8_BAR;
    }
    PG8_WAIT_V(0);
    PG8_BAR;
#undef PG8_SA
#undef PG8_SB
#undef PG8_STAGE
#undef dlt_voffA
#undef dlt_voffB
#undef PG8_LDA
#undef PG8_LDB
#undef PG8_MMA
#undef PG8_MMAZ
#undef PG8_WAIT_V
#undef PG8_WAIT_L
#undef PG8_BAR
#undef PG8_SCHED
}
}

constexpr size_t MiB = 1u << 20;
constexpr size_t WS_CTL = 0, CTL_ZERO_BYTES = 128 * 1024;
constexpr size_t WS_SS = 1 * MiB;
constexpr size_t SS_BYTES = (size_t)M * 4 * 4;
constexpr size_t WS_W1T = 3 * MiB, WS_W3T = 7 * MiB, WS_TOEP = 11 * MiB, WS_LAM = 12 * MiB;
constexpr size_t WS_WGU = 13 * MiB;
constexpr size_t WS_WD = 24 * MiB;
constexpr size_t WS_WIN = WS_WD + (size_t)D * FF * 2;
constexpr size_t WS_WCO = WS_WIN + (size_t)NIN * D * 2;
constexpr size_t WS_WGLU = WS_WCO + (size_t)D * D * 2;
constexpr size_t WS_WO = WS_WGLU + (size_t)2 * D * D * 2;
constexpr size_t WS_XA = 50 * MiB;
constexpr size_t SLOT = (size_t)M * D * 2;
constexpr size_t WS_R = 84 * MiB;
constexpr size_t WS_END = WS_R + 5 * SLOT;
static_assert(WS_WO + (size_t)D * D * 2 <= WS_XA && WS_XA + SLOT <= WS_R && WS_END <= 256 * MiB && (size_t)M * FF * 2 <= 4 * SLOT, "d_ws map");
constexpr int CW_BAR = 1024;
constexpr int CW_FIN = 16384;
constexpr int CW_ZX = 24576;
constexpr int CW_ZF = 4992;
constexpr int CW_CNT = 5120;

#define XB_TMO      128
#define XB_XCNT(j)  (256  + 64 * (j))
#define XB_XSUB(j)  (1280 + 64 * (j))
#define XB_XGEN(j)  (2304 + 64 * (j))
#define XB_TOP      3328
#define XB_TOPGEN   3392
#define XCD_BAR_WORDS 3456
#define XB_SPIN_CAP (1u << 20)
__device__ __forceinline__ unsigned xb_ld(unsigned* p)              { return __hip_atomic_load(p, __ATOMIC_RELAXED, __HIP_MEMORY_SCOPE_AGENT); }
__device__ __forceinline__ unsigned xb_add(unsigned* p, unsigned v) { return __hip_atomic_fetch_add(p, v, __ATOMIC_RELAXED, __HIP_MEMORY_SCOPE_AGENT); }
__device__ __forceinline__ unsigned xb_xcc_id() { return (unsigned)__builtin_amdgcn_s_getreg((3 << 11) | 20) & 0xFu; }
#define XB_SPIN(cond, bar) do { unsigned _sp = 0; while (cond) { __builtin_amdgcn_s_sleep(1); \
    if ((++_sp & 255u) == 0u) { if (xb_ld(&(bar)[XB_TMO])) break; if (_sp > XB_SPIN_CAP) { atomicAdd(&(bar)[XB_TMO], 1u); break; } } } } while (0)
struct XcdBarrier { unsigned* bar; unsigned x; volatile LAS unsigned* st; };
__device__ __forceinline__ XcdBarrier xcd_barrier_post(unsigned* bar, volatile LAS unsigned* st) {
    XcdBarrier b; b.bar = bar; b.x = xb_xcc_id(); b.st = st;
    if (threadIdx.x == 0) (void)xb_add(&bar[XB_XCNT(b.x)], 1u);
    return b;
}
__device__ __forceinline__ void xcd_barrier_complete(unsigned* bar, unsigned x, unsigned& nloc, unsigned& nx) {
    const unsigned G = gridDim.x * gridDim.y * gridDim.z;
    unsigned sum, cnt, mine, sp = 0u;
    for (;;) {
        sum = 0u; cnt = 0u; mine = 0u;
#pragma unroll
        for (unsigned j = 0; j < 16; ++j) { const unsigned c = xb_ld(&bar[XB_XCNT(j)]); sum += c; cnt += (c > 0u) ? 1u : 0u; mine = (j == x) ? c : mine; }
        if (sum == G) break;
        __builtin_amdgcn_s_sleep(1);
        if ((++sp & 255u) == 0u) { if (xb_ld(&bar[XB_TMO])) break; if (sp > XB_SPIN_CAP) { atomicAdd(&bar[XB_TMO], 1u); break; } }
    }
    nloc = mine > 0u ? mine : 1u; nx = cnt > 0u ? cnt : 1u;
}
__device__ __forceinline__ void xcd_barrier(const XcdBarrier& b) {
    asm volatile("s_waitcnt vmcnt(0)" ::: "memory");
    __syncthreads();
    if (threadIdx.x == 0) {
        unsigned* bar = b.bar;
        __builtin_amdgcn_s_waitcnt(0);
        unsigned nloc = b.st[0], nx = b.st[1];
        if (nloc == 0u) { xcd_barrier_complete(bar, b.x, nloc, nx); b.st[0] = nloc; b.st[1] = nx; }
        const unsigned old = xb_add(&bar[XB_XSUB(b.x)], 1u);
        const unsigned gen = old / nloc;
        if (old + 1u == (gen + 1u) * nloc) {
            __builtin_amdgcn_fence(__ATOMIC_RELEASE, "agent");
            asm volatile("s_waitcnt vmcnt(0)" ::: "memory");
            const unsigned og = xb_add(&bar[XB_TOP], 1u);
            const unsigned tg = og / nx;
            if (og + 1u == (tg + 1u) * nx) xb_add(&bar[XB_TOPGEN], 1u);
            else XB_SPIN(xb_ld(&bar[XB_TOPGEN]) == tg, bar);
            __builtin_amdgcn_fence(__ATOMIC_ACQUIRE, "agent");
            asm volatile("s_waitcnt vmcnt(0)" ::: "memory");
            xb_add(&bar[XB_XGEN(b.x)], 1u);
            asm volatile("s_waitcnt vmcnt(0)" ::: "memory");
        } else {
            __builtin_amdgcn_fence(__ATOMIC_ACQUIRE, "agent");
            XB_SPIN(xb_ld(&bar[XB_XGEN(b.x)]) == gen, bar);
            asm volatile("s_waitcnt vmcnt(0)" ::: "memory");
        }
    }
    __syncthreads();
}

struct Args {
    const float* in[28]; float* out; unsigned char* ws; int ph_lo, ph_hi;
};
#define LDS_WAIT() asm volatile("s_waitcnt lgkmcnt(0)" ::: "memory")

__device__ __forceinline__ float wave_sum(float v) {
#pragma unroll
    for (int o = 1; o < 64; o <<= 1) v += __shfl_xor(v, o);
    return v;
}

__device__ __forceinline__ void transpose_item(const float* W, int N, bf16_t* WT, int K, int drow0, const float* gain, LAS float* scr, int k0, int n0, int lane) {
    const int l15 = lane & 15, q = lane >> 4;
    f32x4 v[16];
#pragma unroll
    for (int i = 0; i < 16; ++i) v[i] = __builtin_nontemporal_load((const f32x4*)(W + (size_t)(k0 + 4 * i + q) * N + n0 + 4 * l15));
#pragma unroll
    for (int i = 0; i < 16; ++i) { const int kk = 4 * i + q; const float gsc = gain ? gain[k0 + kk] : 1.0f; LAS float* d = scr + kk * 65 + 4 * l15;
        d[0] = v[i][0] * gsc; d[1] = v[i][1] * gsc; d[2] = v[i][2] * gsc; d[3] = v[i][3] * gsc; }
    LDS_WAIT(); asm volatile("" ::: "memory");
    const int c = lane & 7;
#pragma unroll
    for (int j = 0; j < 8; ++j) { const int n = (lane >> 3) + 8 * j; const LAS float* sp = scr + (8 * c) * 65 + n;
        u32x4 o; o.x = cvt_pk_bf16(sp[0 * 65], sp[1 * 65]); o.y = cvt_pk_bf16(sp[2 * 65], sp[3 * 65]); o.z = cvt_pk_bf16(sp[4 * 65], sp[5 * 65]); o.w = cvt_pk_bf16(sp[6 * 65], sp[7 * 65]);
        *(u32x4*)(WT + (size_t)(drow0 + n) * K + k0 + 8 * c) = o; }
    LDS_WAIT(); asm volatile("" ::: "memory");
}
__device__ __forceinline__ int pair_lo(int n) { return 256 * (n >> 7) + (n & 127); }
__device__ __forceinline__ int pair_hi(int n) { return 256 * (n >> 7) + 128 + (n & 127); }
constexpr int IT_GU = (D / 64) * (FF / 64), IT_DN = (FF / 64) * (D / 64), IT_FFN = 2 * IT_GU + IT_DN;
__device__ __forceinline__ void conv_ffn_item(int r, const float* wg, const float* wu, const float* wd, const float* gain, bf16_t* WGU, bf16_t* WDt, LAS float* scr, int lane) {
    if (r < IT_GU) { const int kb = r / (FF / 64), nb = r % (FF / 64); transpose_item(wg, FF, WGU, D, pair_lo(64 * nb), gain, scr, 64 * kb, 64 * nb, lane); return; } r -= IT_GU;
    if (r < IT_GU) { const int kb = r / (FF / 64), nb = r % (FF / 64); transpose_item(wu, FF, WGU, D, pair_hi(64 * nb), gain, scr, 64 * kb, 64 * nb, lane); return; } r -= IT_GU;
    { const int kb = r / (D / 64), nb = r % (D / 64); transpose_item(wd, D, WDt, FF, 64 * nb, nullptr, scr, 64 * kb, 64 * nb, lane); }
}

constexpr int IT_WIN = (D / 64) * (NIN / 64), IT_CO = (D / 64) * (D / 64), IT_GLU = (D / 64) * (2 * D / 64), IT_O = IT_CO;
constexpr int ITB_FFN2 = IT_FFN, ITB_WIN = 2 * IT_FFN, ITB_CO = ITB_WIN + IT_WIN, ITB_GLU = ITB_CO + IT_CO, ITB_O = ITB_GLU + IT_GLU, ITB_END = ITB_O + IT_O;
__device__ __forceinline__ void conv_range(const Args& a, LAS unsigned char* lds, int lo, int hi, int idx, int n, int wave, int lane) {
    unsigned char* ws = a.ws; LAS float* scr = (LAS float*)(lds + wave * 16896);
    bf16_t* WGU = (bf16_t*)(ws + WS_WGU); bf16_t* WDt = (bf16_t*)(ws + WS_WD); bf16_t* WIN = (bf16_t*)(ws + WS_WIN); bf16_t* WCO = (bf16_t*)(ws + WS_WCO); bf16_t* WGLU = (bf16_t*)(ws + WS_WGLU); bf16_t* WOt = (bf16_t*)(ws + WS_WO);
    bf16_t* WGU1 = (bf16_t*)a.out; bf16_t* WD1 = WGU1 + (size_t)2 * FF * D;
    for (int it = lo + idx; it < hi; it += n) {
        int r = it;
        if (r < IT_FFN) { conv_ffn_item(r, a.in[6], a.in[7], a.in[8], a.in[5], WGU1, WD1, scr, lane); continue; } r -= IT_FFN;
        if (r < IT_FFN) { conv_ffn_item(r, a.in[24], a.in[25], a.in[26], a.in[23], WGU, WDt, scr, lane); continue; } r -= IT_FFN;
        if (r < IT_WIN) { const int kb = r / (NIN / 64), nb = r % (NIN / 64), n0 = 64 * nb; const int dr = n0 < 1024 ? pair_lo(n0) : (n0 < 2048 ? pair_hi(n0 - 1024) : n0);
            transpose_item(a.in[10], NIN, WIN, D, dr, a.in[9], scr, 64 * kb, n0, lane); continue; } r -= IT_WIN;
        if (r < IT_CO) { const int kb = r / (D / 64), nb = r % (D / 64); transpose_item(a.in[12], D, WCO, D, 64 * nb, nullptr, scr, 64 * kb, 64 * nb, lane); continue; } r -= IT_CO;
        if (r < IT_GLU) { const int kb = r / (2 * D / 64), nb = r % (2 * D / 64), n0 = 64 * nb; const int dr = n0 < 1024 ? pair_lo(n0) : pair_hi(n0 - 1024);
            transpose_item(a.in[21], 2 * D, WGLU, D, dr, nullptr, scr, 64 * kb, n0, lane); continue; } r -= IT_GLU;
        { const int kb = r / (D / 64), nb = r % (D / 64); transpose_item(a.in[22], D, WOt, D, 64 * nb, nullptr, scr, 64 * kb, 64 * nb, lane); }
    }
}

typedef float cplx __attribute__((ext_vector_type(2)));
#define CX(a, b) ((cplx){(a), (b)})
__device__ __forceinline__ cplx cmul(cplx a, cplx b) { return CX(a.x * b.x - a.y * b.y, a.x * b.y + a.y * b.x); }
__device__ __forceinline__ cplx cfma(cplx a, cplx b, cplx c) { return CX(fmaf(a.x, b.x, fmaf(-a.y, b.y, c.x)), fmaf(a.x, b.y, fmaf(a.y, b.x, c.y))); }

__device__ __forceinline__ void ssm_tables_job(const Args& a, LAS unsigned char* lds, int g, int part, int tid) {
    LAS cplx* pw = (LAS cplx*)lds;
    LAS cplx* bb = pw + 17 * 64;
    LAS cplx* cc = bb + 64 * 16;
    LAS float* kt = (LAS float*)(cc + 16 * 64);
    const float* lam_re = a.in[13] + g * NP; const float* lam_im = a.in[14] + g * NP; const float stepv = expf(a.in[15][g]);
    const float* b_re = a.in[16] + (size_t)g * NP * 16; const float* b_im = a.in[17] + (size_t)g * NP * 16;
    const float* c_re = a.in[18] + (size_t)g * 16 * NP; const float* c_im = a.in[19] + (size_t)g * 16 * NP; const float* dsk = a.in[20] + g * 16;
    unsigned char* ws = a.ws;
    for (int idx = tid; idx < 17 * 64; idx += 512) { const int tau = idx >> 6, p = idx & 63;
        const float zr = (float)tau * stepv * lam_re[p]; const double zt = (double)tau * (double)stepv * (double)lam_im[p] * 0.15915494309189535;
        const float rt = (float)(zt - rint(zt));
        const float mag = __builtin_amdgcn_exp2f(zr * 1.4426950409f); pw[idx] = CX(mag * __builtin_amdgcn_cosf(rt), mag * __builtin_amdgcn_sinf(rt)); }
    for (int idx = tid; idx < 64 * 16; idx += 512) { const int p = idx >> 4;
        const float lr = lam_re[p], li = lam_im[p], zr = stepv * lr; const double zt = (double)stepv * (double)li * 0.15915494309189535; const float rt = (float)(zt - rint(zt));
        const float ex1 = zr * (1.0f + zr * (0.5f + zr * (0.16666667f + zr * (0.041666668f + zr * 0.0083333338f))));
        const float sn = __builtin_amdgcn_sinf(rt), cs = __builtin_amdgcn_cosf(rt), sh = __builtin_amdgcn_sinf(0.5f * rt);
        const float nr = ex1 * cs - 2.0f * sh * sh, ni = (ex1 + 1.0f) * sn;
        const float den = 1.0f / (lr * lr + li * li); const cplx q = CX((nr * lr + ni * li) * den, (ni * lr - nr * li) * den);
        bb[idx] = cmul(q, CX(b_re[idx], b_im[idx])); }
    for (int idx = tid; idx < 16 * 64; idx += 512) cc[idx] = CX(c_re[idx], c_im[idx]);
    __syncthreads();
    {
        bf16_t* W1T = (bf16_t*)(ws + WS_W1T) + (size_t)g * 32768;
        for (int o8 = part * 1024 + tid; o8 < part * 1024 + 1024; o8 += 512) { const int lane = o8 & 63, nt = (o8 >> 6) & 7, ks = o8 >> 9; const int n = nt * 16 + (lane & 15), p = n & 63, isim = n >> 6; float v[8];
#pragma unroll
            for (int jj = 0; jj < 8; ++jj) { const int kk = ks * 32 + 8 * (lane >> 4) + jj, j = kk >> 4, c1 = kk & 15; const cplx pr = cmul(pw[(15 - j) * 64 + p], bb[p * 16 + c1]); v[jj] = isim ? pr.y : pr.x; }
            u32x4 w; w.x = cvt_pk_bf16(v[0], v[1]); w.y = cvt_pk_bf16(v[2], v[3]); w.z = cvt_pk_bf16(v[4], v[5]); w.w = cvt_pk_bf16(v[6], v[7]);
            *(u32x4*)(W1T + (size_t)o8 * 8) = w; }
        bf16_t* W3T = (bf16_t*)(ws + WS_W3T) + (size_t)g * 32768;
        for (int o8 = part * 1024 + tid; o8 < part * 1024 + 1024; o8 += 512) { const int lane = o8 & 63, i = (o8 >> 6) & 15, ks = o8 >> 10; const int c = lane & 15; float v[8];
#pragma unroll
            for (int jj = 0; jj < 8; ++jj) { const int k = ks * 32 + 8 * (lane >> 4) + jj, p = k & 63, isim = k >> 6; const cplx cl = cmul(cc[c * 64 + p], pw[(i + 1) * 64 + p]); v[jj] = isim ? -cl.y : cl.x; }
            u32x4 w; w.x = cvt_pk_bf16(v[0], v[1]); w.y = cvt_pk_bf16(v[2], v[3]); w.z = cvt_pk_bf16(v[4], v[5]); w.w = cvt_pk_bf16(v[6], v[7]);
            *(u32x4*)(W3T + (size_t)o8 * 8) = w; }
        float* KT = (float*)(ws + WS_TOEP) + (size_t)g * 4096;
        for (int idx = part * 1024 + tid; idx < part * 1024 + 1024; idx += 512) { const int tau = idx >> 8, c = (idx >> 4) & 15, c1 = idx & 15; float sa = 0.f, sb = 0.f;
#pragma unroll 8
            for (int p = 0; p < 64; p += 2) { const cplx t0 = cmul(cc[c * 64 + p], pw[tau * 64 + p]), b0 = bb[p * 16 + c1], t1 = cmul(cc[c * 64 + p + 1], pw[tau * 64 + p + 1]), b1 = bb[(p + 1) * 16 + c1];
                sa += t0.x * b0.x - t0.y * b0.y; sb += t1.x * b1.x - t1.y * b1.y; }
            float sv = sa + sb; if (tau == 0 && c == c1) sv += dsk[c];
            KT[idx] = sv; }
        if (part == 0 && tid < 64) ((cplx*)(ws + WS_LAM))[g * 64 + tid] = pw[16 * 64 + tid];
    }
    __syncthreads();
}

constexpr int L_US = 0, L_SL = 67584, L_SIN = 101376, L_TOEP = 118784, L_ASEG = 135168, L_CARRY = 139264;
struct SsmFrags { bf16x8 w1[8]; bf16x8 w3[2][4]; cplx lam; };
#define LBAR() do { asm volatile("s_waitcnt lgkmcnt(0)" ::: "memory"); __builtin_amdgcn_s_barrier(); asm volatile("" ::: "memory"); } while (0)
template <bool SAMPLE>
__device__ __forceinline__ void ssm_tile(const Args& a, LAS unsigned char* lds, int g, int row0, int tile, bool first, bool last, int seq, const SsmFrags& F, bool has_next_tile, int tid, bf16_t* Yg) {
    const int wid = __builtin_amdgcn_readfirstlane(tid >> 6), lane = tid & 63, l15 = lane & 15, q = lane >> 4;
    unsigned char* ws = a.ws;
    bf16_t* Ug = (bf16_t*)(ws + WS_R + 2 * SLOT) + ((size_t)g * M + row0) * 16;
    const int ub = L_US + (tile & 1) * 33792, ubn = L_US + ((tile + 1) & 1) * 33792;
    u32x4 pf[4];
    if (has_next_tile) {
#pragma unroll
        for (int k = 0; k < 4; ++k) pf[k] = ((const u32x4*)(Ug + 16384))[tid + 512 * k]; }
#pragma unroll
    for (int rb = 0; rb < 4; ++rb) { f32x4 acc = {0.f, 0.f, 0.f, 0.f};
#pragma unroll
        for (int ks = 0; ks < 8; ++ks) { const bf16x8 av = *(const LAS bf16x8*)(lds + ub + (rb * 16 + l15) * 528 + ks * 64 + q * 16); acc = __builtin_amdgcn_mfma_f32_16x16x32_bf16(F.w1[ks], av, acc, 0, 0, 0); }
        *(LAS f32x4*)(lds + L_SL + ((rb * 16 + l15) * 132 + wid * 16 + q * 4) * 4) = acc; }
    LBAR();
    {
        const int p = lane, seg = wid; const LAS float* Sl = (const LAS float*)(lds + L_SL); LAS bf16_t* Sin = (LAS bf16_t*)(lds + L_SIN);
        const cplx L1 = F.lam;
        if (!SAMPLE) {
            LAS cplx* Aseg = (LAS cplx*)(lds + L_ASEG); LAS cplx* carry = (LAS cplx*)(lds + L_CARRY);
            cplx sv[8];
#pragma unroll
            for (int c = 0; c < 8; ++c) { const int ch = seg * 8 + c; sv[c] = CX(Sl[ch * 132 + p], Sl[ch * 132 + 64 + p]); }
            cplx acc = CX(0.f, 0.f);
#pragma unroll
            for (int c = 0; c < 8; ++c) acc = cfma(L1, acc, sv[c]);
            Aseg[seg * 64 + p] = acc;
            LBAR();
            const cplx L2 = cmul(L1, L1), L4 = cmul(L2, L2), L8 = cmul(L4, L4);
            cplx x = first ? CX(0.f, 0.f) : carry[(tile & 1) * 64 + p];
            for (int s = 0; s < seg; ++s) x = cfma(L8, x, Aseg[s * 64 + p]);
#pragma unroll
            for (int c = 0; c < 8; ++c) { const int ch = seg * 8 + c; Sin[ch * 136 + p] = (bf16_t)(cvt_pk_bf16(x.x, 0.f) & 0xffffu); Sin[ch * 136 + 64 + p] = (bf16_t)(cvt_pk_bf16(x.y, 0.f) & 0xffffu);
                x = cfma(L1, x, sv[c]); }
            if (seg == 7) { carry[((tile + 1) & 1) * 64 + p] = x;
                if (last) { a.out[O_SREP + ((size_t)seq * NG + g) * NP + p] = x.x; a.out[O_SIMP + ((size_t)seq * NG + g) * NP + p] = x.y; } }
        } else {
#pragma unroll
            for (int sq = 0; sq < 4; ++sq) { const int s = seg * 4 + sq; const size_t so = ((size_t)s * NG + g) * NP + p;
                cplx x = CX(a.in[3][so], a.in[4][so]);
#pragma unroll
                for (int c = 0; c < 2; ++c) { const int ch = 2 * s + c; Sin[ch * 136 + p] = (bf16_t)(cvt_pk_bf16(x.x, 0.f) & 0xffffu); Sin[ch * 136 + 64 + p] = (bf16_t)(cvt_pk_bf16(x.y, 0.f) & 0xffffu);
                    x = cfma(L1, x, CX(Sl[ch * 132 + p], Sl[ch * 132 + 64 + p])); }
                a.out[O_SRES + so] = x.x; a.out[O_SIMS + so] = x.y; }
        }
    }
    LBAR();
    {
        f32x4 acc[2][4];
#pragma unroll
        for (int t2 = 0; t2 < 2; ++t2)
#pragma unroll
            for (int rb = 0; rb < 4; ++rb) acc[t2][rb] = (f32x4){0.f, 0.f, 0.f, 0.f};
#pragma unroll
        for (int ks = 0; ks < 4; ++ks)
#pragma unroll
            for (int rb = 0; rb < 4; ++rb) { const bf16x8 av = *(const LAS bf16x8*)(lds + L_SIN + (rb * 16 + l15) * 272 + ks * 64 + q * 16);
                acc[0][rb] = __builtin_amdgcn_mfma_f32_16x16x32_bf16(F.w3[0][ks], av, acc[0][rb], 0, 0, 0); acc[1][rb] = __builtin_amdgcn_mfma_f32_16x16x32_bf16(F.w3[1][ks], av, acc[1][rb], 0, 0, 0); }
#pragma unroll
        for (int t2 = 0; t2 < 2; ++t2) { const int i = t2 ? 15 - wid : wid; const int ns = (i >> 1) + 1;
            bf16x8 bfc = *(const LAS bf16x8*)(lds + L_TOEP + (i * 64 + lane) * 16); bf16x8 avc[4];
#pragma unroll
            for (int rb = 0; rb < 4; ++rb) avc[rb] = *(const LAS bf16x8*)(lds + ub + (rb * 16 + l15) * 528 + q * 16);
            for (int s2 = 0; s2 < ns; ++s2) { const int sn = (s2 + 1 < ns) ? s2 + 1 : s2;
                const bf16x8 bfn = *(const LAS bf16x8*)(lds + L_TOEP + ((i - 2 * sn) * 64 + lane) * 16); bf16x8 avn[4];
#pragma unroll
                for (int rb = 0; rb < 4; ++rb) avn[rb] = *(const LAS bf16x8*)(lds + ub + (rb * 16 + l15) * 528 + sn * 64 + q * 16);
#pragma unroll
                for (int rb = 0; rb < 4; ++rb) acc[t2][rb] = __builtin_amdgcn_mfma_f32_16x16x32_bf16(bfc, avc[rb], acc[t2][rb], 0, 0, 0);
                bfc = bfn;
#pragma unroll
                for (int rb = 0; rb < 4; ++rb) avc[rb] = avn[rb]; }
#pragma unroll
            for (int rb = 0; rb < 4; rb += 2) { const f32x4 y0 = acc[t2][rb], y1 = acc[t2][rb + 1]; f32x4 r0, r1;
                sigmoid8(y0 * (1.0f + 0.044715f * y0 * y0), y1 * (1.0f + 0.044715f * y1 * y1), -1.4426950409f * 1.5957691216f, r0, r1);
                const f32x4 o0 = y0 * r0, o1 = y1 * r1; u32x2 w0, w1; w0.x = cvt_pk_bf16(o0[0], o0[1]); w0.y = cvt_pk_bf16(o0[2], o0[3]); w1.x = cvt_pk_bf16(o1[0], o1[1]); w1.y = cvt_pk_bf16(o1[2], o1[3]);
                *(LAS u32x2*)(lds + L_SL + (rb * 16 + l15) * 528 + i * 32 + q * 8) = w0; *(LAS u32x2*)(lds + L_SL + ((rb + 1) * 16 + l15) * 528 + i * 32 + q * 8) = w1; } }
    }
    LBAR();
#pragma unroll
    for (int k = 0; k < 4; ++k) { const int i = tid + 512 * k; const u32x4 v = *(const LAS u32x4*)(lds + L_SL + (i >> 5) * 528 + (i & 31) * 16); ((u32x4*)Yg)[i] = v; }
    if (has_next_tile) {
#pragma unroll
        for (int k = 0; k < 4; ++k) { const int i = tid + 512 * k; *(LAS u32x4*)(lds + ubn + (i >> 5) * 528 + (i & 31) * 16) = pf[k]; } }
    LBAR();
}
__device__ __forceinline__ void ssm_item_begin(const Args& a, LAS unsigned char* lds, int g, int row0, SsmFrags& F, int tid) {
    const int wid = __builtin_amdgcn_readfirstlane(tid >> 6), lane = tid & 63;
    unsigned char* ws = a.ws;
    const bf16_t* W1T = (const bf16_t*)(ws + WS_W1T) + (size_t)g * 32768; const bf16_t* W3T = (const bf16_t*)(ws + WS_W3T) + (size_t)g * 32768;
    const bf16_t* Ug = (const bf16_t*)(ws + WS_R + 2 * SLOT) + ((size_t)g * M + row0) * 16;
    u32x4 uv[4]; f32x4 ka[2][2];
#pragma unroll
    for (int k = 0; k < 4; ++k) uv[k] = ((const u32x4*)Ug)[tid + 512 * k];
    const float* KT = (const float*)(ws + WS_TOEP) + (size_t)g * 4096;
#pragma unroll
    for (int k = 0; k < 2; ++k) { const int o8 = tid + 512 * k, ln = o8 & 63, d = o8 >> 6, qq = ln >> 4, dd = d - (qq >> 1); const float* src = KT + (dd < 0 ? 0 : dd) * 256 + (ln & 15) * 16 + 8 * (qq & 1);
        ka[k][0] = *(const f32x4*)src; ka[k][1] = *(const f32x4*)(src + 4); if (dd < 0) { ka[k][0] = (f32x4){0.f, 0.f, 0.f, 0.f}; ka[k][1] = (f32x4){0.f, 0.f, 0.f, 0.f}; } }
#pragma unroll
    for (int ks = 0; ks < 8; ++ks) F.w1[ks] = *(const bf16x8*)(W1T + ((size_t)(ks * 8 + wid) * 64 + lane) * 8);
#pragma unroll
    for (int t2 = 0; t2 < 2; ++t2) { const int i = t2 ? 15 - wid : wid;
#pragma unroll
        for (int ks = 0; ks < 4; ++ks) F.w3[t2][ks] = *(const bf16x8*)(W3T + ((size_t)(ks * 16 + i) * 64 + lane) * 8); }
    F.lam = ((const cplx*)(ws + WS_LAM))[g * 64 + lane];
#pragma unroll
    for (int k = 0; k < 4; ++k) { const int i = tid + 512 * k; *(LAS u32x4*)(lds + L_US + (i >> 5) * 528 + (i & 31) * 16) = uv[k]; }
#pragma unroll
    for (int k = 0; k < 2; ++k) { u32x4 w; w.x = cvt_pk_bf16(ka[k][0][0], ka[k][0][1]); w.y = cvt_pk_bf16(ka[k][0][2], ka[k][0][3]); w.z = cvt_pk_bf16(ka[k][1][0], ka[k][1][1]); w.w = cvt_pk_bf16(ka[k][1][2], ka[k][1][3]);
        *(LAS u32x4*)(lds + L_TOEP + (tid + 512 * k) * 16) = w; }
    LDS_WAIT(); __syncthreads();
}

typedef float f32x8 __attribute__((ext_vector_type(8)));
__device__ __forceinline__ f32x8 bf8_to_f32(u32x4 v) { return (f32x8){bf_lo(v.x), bf_hi(v.x), bf_lo(v.y), bf_hi(v.y), bf_lo(v.z), bf_hi(v.z), bf_lo(v.w), bf_hi(v.w)}; }
__device__ __forceinline__ f32x8 ld_f32x8(const float* p) { const f32x4 a = *(const f32x4*)p, b = *(const f32x4*)(p + 4); return (f32x8){a[0], a[1], a[2], a[3], b[0], b[1], b[2], b[3]}; }
template <int NR>
__device__ __forceinline__ void conv_rows(const float* cstate, const bf16_t* Z, const bf16_t* BG, bf16_t* ZC, int r0, int c0, f32x8 w0, f32x8 w1, f32x8 w2, f32x8& z1, f32x8& z2) {
    u32x4 zv[NR], bv[NR];
#pragma unroll
    for (int rr = 0; rr < NR; ++rr) { zv[rr] = *(const u32x4*)(Z + (size_t)(r0 + rr) * D + c0); bv[rr] = *(const u32x4*)(BG + (size_t)(r0 + rr) * D + c0); }
#pragma unroll
    for (int rr = 0; rr < NR; ++rr) { const int row = r0 + rr;
        const bool st = (row < MP) ? ((row & 4095) == 0) : (((row - MP) & 31) == 0);
        if (st) { if (row < MP) { z1 = (f32x8)(0.f); z2 = (f32x8)(0.f); }
            else { const int s = (row - MP) >> 5; const float* pv = cstate + (size_t)s * 2 * D + c0; z2 = ld_f32x8(pv); z1 = ld_f32x8(pv + D); } }
        const f32x8 z0 = bf8_to_f32(zv[rr]), b0 = bf8_to_f32(bv[rr]);
        const f32x8 o = b0 * (w0 * z2 + w1 * z1 + w2 * z0); z2 = z1; z1 = z0;
        u32x4 w; w.x = cvt_pk_bf16(o[0], o[1]); w.y = cvt_pk_bf16(o[2], o[3]); w.z = cvt_pk_bf16(o[4], o[5]); w.w = cvt_pk_bf16(o[6], o[7]);
        *(u32x4*)(ZC + (size_t)row * D + c0) = w; }
}

constexpr int NPHASE = 10;
__global__ void __launch_bounds__(512, 2) mk_fwd(Args a) {
    extern __shared__ __attribute__((aligned(16))) unsigned char lds_raw[];
    LAS unsigned char* lds = (LAS unsigned char*)lds_raw;
    const int tid = threadIdx.x, lane = tid & 63, wave = __builtin_amdgcn_readfirstlane(tid >> 6);
    const int G = gridDim.x; const int bx = blockIdx.x; const int vcu = (G % 8 == 0) ? (bx % 8) * (G / 8) + bx / 8 : bx;
    unsigned char* ws = a.ws;
    volatile LAS unsigned* MISC = (volatile LAS unsigned*)(lds + LDSCTL_OFF);
    if (tid < 64) MISC[tid] = 0u;
    __syncthreads();
    XcdBarrier bar; bar.bar = (unsigned*)(ws + WS_CTL) + CW_BAR; bar.x = 0; bar.st = nullptr;
    const int lo = a.ph_lo, hi = a.ph_hi;
    if (hi - lo > 1) bar = xcd_barrier_post((unsigned*)(ws + WS_CTL) + CW_BAR, MISC + 8);
#define IN(k) (lo <= (k) && (k) < hi)
#define SEAM(k) do { if (IN(k) && IN((k) + 1)) xcd_barrier(bar); } while (0)
#ifndef DUP_PHASE
#define DUP_PHASE -1
#endif
#define REPS(k) ((DUP_PHASE) == (k) ? 2 : 1)
#define REP(k) for (int rep_ = 0; rep_ < REPS(k); ++rep_, (rep_ < REPS(k) ? xcd_barrier(bar) : (void)0))

    bf16_t* WGU = (bf16_t*)(ws + WS_WGU); bf16_t* WDt = (bf16_t*)(ws + WS_WD); bf16_t* WIN = (bf16_t*)(ws + WS_WIN); bf16_t* WCO = (bf16_t*)(ws + WS_WCO);
    bf16_t* WGLU = (bf16_t*)(ws + WS_WGLU); bf16_t* WOt = (bf16_t*)(ws + WS_WO); bf16_t* XA = (bf16_t*)(ws + WS_XA);
    bf16_t* R0 = (bf16_t*)(ws + WS_R); bf16_t* R1 = (bf16_t*)(ws + WS_R + SLOT); bf16_t* R2 = (bf16_t*)(ws + WS_R + 2 * SLOT); bf16_t* R3 = (bf16_t*)(ws + WS_R + 3 * SLOT); bf16_t* R4 = (bf16_t*)(ws + WS_R + 4 * SLOT);
    bf16_t* HB = R0;
    bf16_t* WGU1 = (bf16_t*)a.out; bf16_t* WD1 = WGU1 + (size_t)2 * FF * D;
    float* ss0 = (float*)(ws + WS_SS); float* ss1 = (float*)(ws + WS_SS + SS_BYTES); float* ss2 = (float*)(ws + WS_SS + 2 * SS_BYTES); float* ss3 = (float*)(ws + WS_SS + 3 * SS_BYTES);
    float* Y = a.out + O_Y;
    u32x2* PD2 = (u32x2*)((unsigned char*)a.out + 17 * MiB); u32x2* PDO = (u32x2*)a.out; u32x2* PD9 = (u32x2*)(ws + WS_XA);
    const int gw = vcu * 8 + wave, NGW = G * 8;

    if (IN(0)) REP(0) {
        const bool tables_first = (bx & 1) != 0;
        if (tables_first) for (int job = vcu; job < NG * 4; job += G) ssm_tables_job(a, lds, job >> 2, job & 3, tid);
        conv_range(a, lds, 0, 2 * IT_GU, wave * G + vcu, NGW, wave, lane);
        for (int m0 = gw; m0 < M; m0 += 4 * NGW) {
            f32x4 v[4][4]; int mr[4];
#pragma unroll
            for (int r = 0; r < 4; ++r) { const int m = m0 + r * NGW; mr[r] = m < M ? m : m0; const float* xr = (mr[r] < MP) ? a.in[0] + (size_t)mr[r] * D : a.in[1] + (size_t)(mr[r] - MP) * D;
#pragma unroll
                for (int j = 0; j < 4; ++j) v[r][j] = __builtin_nontemporal_load((const f32x4*)xr + lane + 64 * j); }
#pragma unroll
            for (int r = 0; r < 4; ++r) { if (r > 0 && m0 + r * NGW >= M) break; float sq = 0.f;
#pragma unroll
                for (int j = 0; j < 4; ++j) sq += (v[r][j][0] * v[r][j][0] + v[r][j][1] * v[r][j][1]) + (v[r][j][2] * v[r][j][2] + v[r][j][3] * v[r][j][3]);
                sq = wave_sum(sq);
#pragma unroll
                for (int j = 0; j < 4; ++j) { u32x2 w; w.x = cvt_pk_bf16(v[r][j][0], v[r][j][1]); w.y = cvt_pk_bf16(v[r][j][2], v[r][j][3]); ((u32x2*)(XA + (size_t)mr[r] * D))[lane + 64 * j] = w; }
                if (lane == 0) *(f32x4*)(ss0 + (size_t)mr[r] * 4) = (f32x4){sq, 0.f, 0.f, 0.f}; }
        }
        __syncthreads();
        if (!tables_first) for (int job = vcu; job < NG * 4; job += G) ssm_tables_job(a, lds, job >> 2, job & 3, tid);
    }
    SEAM(0);
    if (IN(1)) REP(1) { pg8::Gemm g{XA, WGU1, M, 2 * FF, D, 2 * D, 32}; pg8::StaticOrder S; S.init(M, 2 * FF, D, G, bx, 1); pg8::EpiSwiGLU E{HB, ss0}; pg8::gemm_phase<false>(lds, g, S, E, nullptr, nullptr);
        if (S.r > 0 && bx >= S.r) { const int nw = (G - S.r) * 8; conv_range(a, lds, 2 * IT_GU, IT_FFN, (bx - S.r) * 8 + wave, nw, wave, lane); __syncthreads(); } }
    SEAM(1);
    if (IN(2)) REP(2) { pg8::Gemm g{HB, WD1, M, D, FF, 2 * FF, 32}; pg8::StaticOrder S; S.init(M, D, FF, G, bx, NSPLIT); pg8::EpiResid<true, false, true> E{nullptr, nullptr, XA, nullptr, XA, ss1, 0.5f};   pg8::gemm_phase<true>(lds, g, S, E, PD2, (unsigned*)(ws + WS_CTL) + CW_CNT + 0 * 2048);
        { const int nt_ = S.ns > 1 ? S.r * S.ns : 0; if (bx >= nt_ && nt_ < G) { const int nw = (G - nt_) * 8; conv_range(a, lds, ITB_WIN, (G - nt_ > NG) ? ITB_GLU : ITB_END, (bx - nt_) * 8 + wave, nw, wave, lane); __syncthreads(); } } }
    SEAM(2);
    if (IN(3)) { pg8::Gemm g{XA, WIN, M, NIN, D, 2 * D, 32}; pg8::ZFirstOrder S; unsigned* zdone = (unsigned*)(ws + WS_CTL) + CW_ZF; S.init(G, bx, zdone, (unsigned*)(ws + WS_CTL) + CW_ZX, bar.x, bar.st);
        pg8::EpiMixIn E{R0, R1, R2, (unsigned char*)R3, (unsigned char*)R4, ss1, a.out};
        pg8::gemm_phase<false>(lds, g, S, E, nullptr, nullptr);
        const int ntot = S.nA + S.nB, rlast = ntot - ((ntot - 1) / G) * G;
        const bool all_conv = (rlast == G);
        if (all_conv || bx >= rlast) {
            if (tid == 0) { unsigned sp = 0; while (__hip_atomic_load(zdone, __ATOMIC_RELAXED, __HIP_MEMORY_SCOPE_AGENT) < (unsigned)S.publishers()) { __builtin_amdgcn_s_sleep(2); if (++sp > (1u << 22)) break; }
                __builtin_amdgcn_fence(__ATOMIC_ACQUIRE, "agent"); asm volatile("s_waitcnt vmcnt(0)" ::: "memory"); }
            __syncthreads();
            const int cw = all_conv ? bx : bx - rlast, ncw = all_conv ? G : G - rlast, nruns = ncw * 4;
            const float* wc = a.in[11]; const float* cstate = a.in[2]; const bf16_t* Z = R0; bf16_t* BG = R1;
            const int run = cw * 4 + (tid >> 7), c0 = (tid & 127) * 8;
            const int r0 = (int)(((long)run * M) / nruns), r1 = (int)(((long)(run + 1) * M) / nruns);
            const f32x8 w0 = ld_f32x8(wc + c0), w1 = ld_f32x8(wc + D + c0), w2 = ld_f32x8(wc + 2 * D + c0); f32x8 z1 = (f32x8)(0.f), z2 = (f32x8)(0.f);
            { const bool st = (r0 < MP) ? ((r0 & 4095) == 0) : (((r0 - MP) & 31) == 0);
              if (!st) { const bool st1 = (r0 < MP) ? (((r0 - 1) & 4095) == 0) : (((r0 - 1 - MP) & 31) == 0);
                  z1 = bf8_to_f32(*(const u32x4*)(Z + (size_t)(r0 - 1) * D + c0));
                  if (!st1) z2 = bf8_to_f32(*(const u32x4*)(Z + (size_t)(r0 - 2) * D + c0));
                  else if (r0 - 1 >= MP) { const int sq = (r0 - 1 - MP) >> 5; z2 = ld_f32x8(cstate + ((size_t)sq * 2 + 1) * D + c0); } } }
            int r = r0;
            for (; r + 9 <= r1; r += 9) { int rr = r; asm volatile("" : "+v"(rr)); conv_rows<9>(cstate, Z, BG, BG, rr, c0, w0, w1, w2, z1, z2); }
            for (; r + 4 <= r1; r += 4) { int rr = r; asm volatile("" : "+v"(rr)); conv_rows<4>(cstate, Z, BG, BG, rr, c0, w0, w1, w2, z1, z2); }
            for (; r < r1; ++r) { int rr = r; asm volatile("" : "+v"(rr)); conv_rows<1>(cstate, Z, BG, BG, rr, c0, w0, w1, w2, z1, z2); }
        }
    }
    SEAM(3);

    if (IN(5)) { pg8::Gemm g{R1, WCO, M, D, D, 2 * D, 32}; pg8::StaticOrder S; S.init(M, D, D, G, bx, NSPLIT); pg8::EpiConvOut E{(const unsigned char*)R3, R0}; pg8::gemm_phase<true>(lds, g, S, E, PDO, (unsigned*)(ws + WS_CTL) + CW_CNT + 1 * 2048);
        { const int ntail = S.ns > 1 ? S.r * S.ns : 0;
          for (int item = vcu; item < NB * NG; item += G) { const int g = item & 63, seq = item >> 6; SsmFrags F; ssm_item_begin(a, lds, g, seq * SEQ, F, tid);
              for (int t = 0; t < 4; ++t) ssm_tile<false>(a, lds, g, seq * SEQ + t * 1024, t, t == 0, t == 3, seq, F, t < 3, tid, R2 + ((size_t)g * M + seq * SEQ + t * 1024) * 16); }
          const int nfree = G - ntail;
          for (int j = (bx >= ntail ? bx - ntail : bx + nfree); j < NG; j += G) { SsmFrags F; ssm_item_begin(a, lds, j, MP, F, tid); ssm_tile<true>(a, lds, j, MP, 0, true, true, 0, F, false, tid, R2 + ((size_t)j * M + MP) * 16); }
          if (nfree > NG && bx >= ntail + NG) { __syncthreads(); conv_range(a, lds, ITB_GLU, ITB_END, (bx - ntail - NG) * 8 + wave, (nfree - NG) * 8, wave, lane); __syncthreads(); }
        }
    }
    SEAM(5);
    if (IN(6)) REP(6) { pg8::Gemm g{R2, WGLU, M, 2 * D, D, 32, 32u * M}; pg8::StaticOrder S; S.init(M, 2 * D, D, G, bx, NSPLIT); pg8::EpiGlu E{R0, (const unsigned char*)R4, R0}; pg8::gemm_phase<true>(lds, g, S, E, PDO, (unsigned*)(ws + WS_CTL) + CW_CNT + 2 * 2048); }
    SEAM(6);
    if (IN(7)) { pg8::Gemm g{R0, WOt, M, D, D, 2 * D, 32}; pg8::StaticOrder S; S.init(M, D, D, G, bx, NSPLIT); pg8::EpiResid<true, false, true> E{nullptr, nullptr, XA, nullptr, R4, ss2, 1.0f}; pg8::gemm_phase<true>(lds, g, S, E, PDO, (unsigned*)(ws + WS_CTL) + CW_CNT + 3 * 2048);
        { const int nt_ = S.ns > 1 ? S.r * S.ns : 0; if (bx >= nt_ && nt_ < G) { conv_range(a, lds, ITB_FFN2, ITB_FFN2 + 2 * IT_GU, (bx - nt_) * 8 + wave, (G - nt_) * 8, wave, lane); __syncthreads(); } } }
    SEAM(7);
    if (IN(8)) REP(8) { pg8::Gemm g{R4, WGU, M, 2 * FF, D, 2 * D, 32}; pg8::StaticOrder S; S.init(M, 2 * FF, D, G, bx, 1); pg8::EpiSwiGLU E{HB, ss2}; pg8::gemm_phase<false>(lds, g, S, E, nullptr, nullptr);
        if (S.r > 0 && bx >= S.r) { conv_range(a, lds, ITB_FFN2 + 2 * IT_GU, ITB_WIN, (bx - S.r) * 8 + wave, (G - S.r) * 8, wave, lane); __syncthreads(); } else if (S.r == 0) { conv_range(a, lds, ITB_FFN2 + 2 * IT_GU, ITB_WIN, bx * 8 + wave, G * 8, wave, lane); __syncthreads(); } }
    SEAM(8);
    const bool fuse_final = (G == 256);
    if (IN(9)) { pg8::Gemm g{HB, WDt, M, D, FF, 2 * FF, 32}; pg8::StaticOrder S;
        if (fuse_final && S.init_tailpanels(M, D, FF, G, bx, MS / 256)) {
            unsigned* fc = (unsigned*)(ws + WS_CTL) + CW_FIN;
            pg8::EpiFinal E{R4, Y, ss3, fc, fc + 64 * (M / 256), a.in[27], 0.5f}; pg8::gemm_phase<true>(lds, g, S, E, PD9, (unsigned*)(ws + WS_CTL) + CW_CNT + 4 * 2048);
        }
    }
    SEAM(9);
#undef IN
#undef SEAM
}

extern "C" void kernel_launch(void* const* d_in, const int* in_sizes, int n_in, void* d_out, int out_size, void* d_ws, size_t ws_size, hipStream_t stream) {
    static int grid = 0;
    if (grid == 0) {
        if (n_in != 28 || ws_size < WS_END) { fprintf(stderr, "kernel_launch: unexpected inputs (n_in %d, ws %zu, need %zu)\n", n_in, ws_size, (size_t)WS_END); grid = -1; return; }
        int dev = 0, cus = 0;
        if (hipGetDevice(&dev) != hipSuccess || hipDeviceGetAttribute(&cus, hipDeviceAttributeMultiprocessorCount, dev) != hipSuccess) { grid = -1; return; }
        if (hipFuncSetAttribute((const void*)mk_fwd, hipFuncAttributeMaxDynamicSharedMemorySize, LDS_BYTES) != hipSuccess) { fprintf(stderr, "kernel_launch: hipFuncSetAttribute failed\n"); grid = -1; return; }
        int per_cu = 0;
        if (hipOccupancyMaxActiveBlocksPerMultiprocessor(&per_cu, (const void*)mk_fwd, 512, LDS_BYTES) != hipSuccess || per_cu < 1) fprintf(stderr, "kernel_launch: occupancy query says %d blocks/CU\n", per_cu);
        (void)hipGetLastError();
        grid = cus > 256 ? 256 : cus;
    }
    if (grid < 0) return;
    (void)hipMemsetAsync((char*)d_ws + WS_CTL, 0, CTL_ZERO_BYTES, stream);
    Args a{};
    for (int i = 0; i < 28; ++i) a.in[i] = (const float*)d_in[i];
    a.out = (float*)d_out; a.ws = (unsigned char*)d_ws;
#if MK_N_LAUNCHES == 1
    a.ph_lo = 0; a.ph_hi = NPHASE;
    hipLaunchKernelGGL(mk_fwd, dim3(grid), dim3(512), LDS_BYTES, stream, a);
#else
    for (int p = 0; p < NPHASE; ++p) { a.ph_lo = p; a.ph_hi = p + 1; hipLaunchKernelGGL(mk_fwd, dim3(grid), dim3(512), LDS_BYTES, stream, a); }
#endif
}
```
